# Optimizing an MI355X kernel written in HIP

```python
import math
import jax
import jax.numpy as jnp
from jax import lax
import numpy as np

D_MODEL = 1024
BATCH = 2
SEQ = 16384
DEPTH = 2

GRID_W = 64
CTX_LEN = 256
ADALN_CHUNKS = 6
RMS_EPS = 1e-6

ATT_HEADS = 8
ATT_KV_HEADS = 2
ATT_GROUP = ATT_HEADS // ATT_KV_HEADS
HEAD_DIM = 64
ATT_WIDTH = ATT_HEADS * HEAD_DIM
ATT_KV_WIDTH = ATT_KV_HEADS * HEAD_DIM
Q_BLOCK = 128
ROPE_THETA = 10000.0

HG_HEADS = 4
HG_DK = 64
HG_DV = 64
HG_WIDTH = HG_HEADS * HG_DK
HG_VWIDTH = HG_HEADS * HG_DV
HG_CHUNK = 128

SSM_WIDTH = 256
SSM_GROUP = 16
SSM_GROUPS = SSM_WIDTH // SSM_GROUP
SSM_STATE = 64

FFN_HIDDEN = ((8 * D_MODEL + 3 * 256 - 1) // (3 * 256)) * 256

IN_SIZES = (ATT_WIDTH, ATT_KV_WIDTH, ATT_KV_WIDTH, HG_WIDTH, HG_WIDTH, HG_WIDTH, HG_VWIDTH, HG_VWIDTH, SSM_WIDTH, D_MODEL, D_MODEL, D_MODEL)
IN_OFFSETS = tuple(int(o) for o in np.cumsum(IN_SIZES)[:-1])
N_IN = sum(IN_SIZES)

kernel_name = 'hybrid_gqa_hgrn2_s5_dit_block'


def rms_norm(x, g):
    xf = x.astype(jnp.float32)
    y = xf * lax.rsqrt(jnp.mean(xf * xf, axis=-1, keepdims=True) + RMS_EPS)
    return (y * g.astype(jnp.float32)).astype(x.dtype)


def modulate(x, g, shift, scale):
    return rms_norm(x, g) * (1.0 + scale) + shift


def split_heads(a, n_heads):
    return a.reshape(a.shape[0], a.shape[1], n_heads, a.shape[-1] // n_heads)


def axial_rope_tables(n_tokens):
    rows = n_tokens // GRID_W
    row_ids = jnp.repeat(jnp.arange(rows, dtype=jnp.float32), GRID_W)
    col_ids = jnp.broadcast_to(jnp.arange(GRID_W, dtype=jnp.float32), (rows, GRID_W)).reshape(-1)
    axis_dim = HEAD_DIM // 2
    inv_freq = ROPE_THETA ** (-jnp.arange(0, axis_dim, 2, dtype=jnp.float32) / axis_dim)
    ang_r = row_ids[:, None] * inv_freq
    ang_c = col_ids[:, None] * inv_freq
    return (jnp.cos(ang_r), jnp.sin(ang_r), jnp.cos(ang_c), jnp.sin(ang_c))


def rotate_pairs(x, cos, sin):
    x1, x2 = jnp.split(x, 2, axis=-1)
    cos, sin = cos[None, :, None, :], sin[None, :, None, :]
    return jnp.concatenate([x1 * cos - x2 * sin, x2 * cos + x1 * sin], axis=-1)


def apply_axial_rope(x, rope):
    cos_r, sin_r, cos_c, sin_c = rope
    x_row, x_col = jnp.split(x.astype(jnp.float32), 2, axis=-1)
    out = jnp.concatenate([rotate_pairs(x_row, cos_r, sin_r), rotate_pairs(x_col, cos_c, sin_c)], axis=-1)
    return out.astype(x.dtype)


def gqa_attend(q, k, v):
    s = jnp.einsum('bqhgd,bkhd->bhgqk', q, k).astype(jnp.float32) * (HEAD_DIM ** -0.5)
    p = jax.nn.softmax(s, axis=-1).astype(v.dtype)
    return jnp.einsum('bhgqk,bkhd->bqhgd', p, v)


def attention_branch(z_ctx, z_lat, q_g, k_g, rope, with_ctx):
    (qc, kc, vc), (ql, kl, vl) = z_ctx, z_lat
    b_, t = ql.shape[0], ql.shape[1]
    t_ctx = qc.shape[1]
    k_ctx = rms_norm(split_heads(kc, ATT_KV_HEADS), k_g)
    v_ctx = split_heads(vc, ATT_KV_HEADS)
    k_lat = apply_axial_rope(rms_norm(split_heads(kl, ATT_KV_HEADS), k_g), rope)
    q_lat = apply_axial_rope(rms_norm(split_heads(ql, ATT_HEADS), q_g), rope)
    k_all = jnp.concatenate([k_ctx, k_lat], axis=1)
    v_all = jnp.concatenate([v_ctx, split_heads(vl, ATT_KV_HEADS)], axis=1)
    q_blocks = q_lat.reshape(b_, t // Q_BLOCK, Q_BLOCK, ATT_KV_HEADS, ATT_GROUP, HEAD_DIM).swapaxes(0, 1)
    o_blocks = lax.map(lambda qb: gqa_attend(qb, k_all, v_all), q_blocks)
    y_lat = o_blocks.swapaxes(0, 1).reshape(b_, t, ATT_WIDTH)
    y_ctx = None
    if with_ctx:
        q_ctx = rms_norm(split_heads(qc, ATT_HEADS), q_g).reshape(b_, t_ctx, ATT_KV_HEADS, ATT_GROUP, HEAD_DIM)
        y_ctx = gqa_attend(q_ctx, k_ctx, v_ctx).reshape(b_, t_ctx, ATT_WIDTH)
    return y_ctx, y_lat


def gla_chunked(q, k, v, log_f, s0):
    b_, t, h, _ = q.shape
    n = t // HG_CHUNK

    def chunks(a):
        return a.reshape(b_, n, HG_CHUNK, h, a.shape[-1]).transpose(1, 0, 3, 2, 4)

    lower = jnp.tril(jnp.ones((HG_CHUNK, HG_CHUNK), dtype=bool))[:, :, None]

    def step(state, inp):
        qc, kc, vc, gc = inp
        cum = jnp.cumsum(gc, axis=2)
        o_inter = jnp.einsum('bhld,bhde->bhle', qc * jnp.exp(cum), state)
        diff = cum[:, :, :, None, :] - cum[:, :, None, :, :]
        decay = jnp.where(lower, jnp.exp(jnp.where(lower, diff, 0.0)), 0.0)
        scores = jnp.einsum('bhtd,bhsd,bhtsd->bhts', qc, kc, decay)
        o = o_inter + jnp.einsum('bhts,bhse->bhte', scores, vc)
        last = cum[:, :, -1:, :]
        state = jnp.exp(last[:, :, 0, :, None]) * state + jnp.einsum('bhsd,bhse->bhde', kc * jnp.exp(last - cum), vc)
        return state, o

    state, o = lax.scan(step, s0, (chunks(q), chunks(k), chunks(v), chunks(log_f)))
    o = o.transpose(1, 0, 3, 2, 4).reshape(b_, t, h, o.shape[-1])
    return o, state


def hgrn_forget(f_pre, lb):
    f_pre = f_pre.astype(jnp.float32)
    f = lb + (1.0 - lb) * jax.nn.sigmoid(f_pre)
    key_in = (1.0 - lb) * jax.nn.sigmoid(-f_pre)
    return split_heads(jnp.log(f), HG_HEADS), split_heads(key_in, HG_HEADS)


def hgrn2_branch(z_ctx, z_lat, lb, norm_g, with_ctx):
    out_dtype = z_lat[0].dtype

    def prep(z):
        q, f_fwd, f_bwd, i, g = z
        q = split_heads(jax.nn.silu(q.astype(jnp.float32)), HG_HEADS)
        v = split_heads(i.astype(jnp.float32), HG_HEADS)
        return q, v, (hgrn_forget(f_fwd, lb[0]), hgrn_forget(f_bwd, lb[1])), g

    qc, vc, fc, gc = prep(z_ctx)
    ql, vl, fl, gl = prep(z_lat)
    o_ctx, o_lat = [], []
    for d, reverse in ((0, False), (1, True)):
        flip = (lambda a: jnp.flip(a, axis=1)) if reverse else (lambda a: a)
        (lf_c, k_c), (lf_l, k_l) = fc[d], fl[d]
        s0 = jnp.zeros((qc.shape[0], HG_HEADS, HG_DK, HG_DV), jnp.float32)
        oc, s_ctx = gla_chunked(flip(qc), flip(k_c), flip(vc), flip(lf_c), s0)
        ol, _ = gla_chunked(flip(ql), flip(k_l), flip(vl), flip(lf_l), s_ctx)
        o_ctx.append(flip(oc))
        o_lat.append(flip(ol))

    def readout(o, g):
        o = rms_norm(o, norm_g).reshape(o.shape[0], o.shape[1], HG_VWIDTH)
        return (o * jax.nn.silu(g.astype(jnp.float32))).astype(out_dtype)

    y_ctx = readout(o_ctx[0] + o_ctx[1], gc) if with_ctx else None
    return y_ctx, readout(o_lat[0] + o_lat[1], gl)


def s5_discretise(lam_re, lam_im, log_dt, b_re, b_im):
    lam = lax.complex(lam_re.astype(jnp.float32), lam_im.astype(jnp.float32))
    dt = jnp.exp(log_dt.astype(jnp.float32))[:, None]
    lam_bar = jnp.exp(lam * dt)
    b = lax.complex(b_re.astype(jnp.float32), b_im.astype(jnp.float32))
    b_bar = ((lam_bar - 1.0) / lam)[..., None] * b
    return lam_bar, b_bar


def linear_recurrence_op(e1, e2):
    a1, b1 = e1
    a2, b2 = e2
    return a1 * a2, a2 * b1 + b2


def s5_scan(u, lam_bar, b_bar, x0, reverse):
    if reverse:
        u = jnp.flip(u, axis=1)
    bu = jnp.einsum('btgc,gpc->tbgp', u.astype(jnp.complex64), b_bar)
    bu = bu.at[0].add(lam_bar * x0)
    a = jnp.broadcast_to(lam_bar, bu.shape)
    _, xs = lax.associative_scan(linear_recurrence_op, (a, bu), axis=0)
    xs = jnp.moveaxis(xs, 0, 1)
    return jnp.flip(xs, axis=1) if reverse else xs


def s5_readout(xs, c_mat):
    return jnp.einsum('btgp,gcp->btgc', xs, c_mat).real


def s5_branch(u_ctx, u_lat, p, with_ctx):
    out_dtype = u_lat.dtype

    def groups(u):
        return u.astype(jnp.float32).reshape(u.shape[0], u.shape[1], SSM_GROUPS, SSM_GROUP)

    uc, ul = groups(u_ctx), groups(u_lat)
    d_skip = p['ssm_d'].astype(jnp.float32).reshape(SSM_GROUPS, SSM_GROUP)
    y_lat = d_skip * ul
    y_ctx = d_skip * uc if with_ctx else None
    for d, reverse in ((0, False), (1, True)):
        lam_bar, b_bar = s5_discretise(p['ssm_lam_re'][d], p['ssm_lam_im'][d], p['ssm_log_dt'][d], p['ssm_b_re'][d], p['ssm_b_im'][d])
        c_mat = lax.complex(p['ssm_c_re'][d].astype(jnp.float32), p['ssm_c_im'][d].astype(jnp.float32))
        x0 = jnp.zeros((uc.shape[0], SSM_GROUPS, SSM_STATE), jnp.complex64)
        xs_ctx = s5_scan(uc, lam_bar, b_bar, x0, reverse)
        x_init = xs_ctx[:, 0] if reverse else xs_ctx[:, -1]
        xs_lat = s5_scan(ul, lam_bar, b_bar, x_init, reverse)
        y_lat = y_lat + s5_readout(xs_lat, c_mat)
        if with_ctx:
            y_ctx = y_ctx + s5_readout(xs_ctx, c_mat)

    def glu(y):
        z = jax.nn.gelu(y.reshape(y.shape[0], y.shape[1], SSM_WIDTH))
        return (z * jax.nn.sigmoid(z @ p['w_glu'] + p['b_glu'])).astype(out_dtype)

    return (glu(y_ctx) if with_ctx else None), glu(y_lat)


def mixer_sublayer(h_ctx, h_lat, p, lb, rope, with_ctx):
    z_ctx = jnp.split(h_ctx @ p['w_in'], IN_OFFSETS, axis=-1)
    z_lat = jnp.split(h_lat @ p['w_in'], IN_OFFSETS, axis=-1)
    a_ctx, a_lat = attention_branch(z_ctx[0:3], z_lat[0:3], p['q_norm_g'], p['k_norm_g'], rope, with_ctx)
    r_ctx, r_lat = hgrn2_branch(z_ctx[3:8], z_lat[3:8], lb, p['hgrn_norm_g'], with_ctx)
    s_ctx, s_lat = s5_branch(z_ctx[8], z_lat[8], p, with_ctx)

    def merge(y_att, y_rec, y_ssm, gates):
        g_att, g_rec, g_ssm = gates
        m = (jax.nn.sigmoid(g_att) * (y_att @ p['w_br_attn'])
             + jax.nn.sigmoid(g_rec) * (y_rec @ p['w_br_hgrn'])
             + jax.nn.sigmoid(g_ssm) * (y_ssm @ p['w_br_ssm']))
        return m @ p['w_out']

    y_lat = merge(a_lat, r_lat, s_lat, z_lat[9:12])
    y_ctx = merge(a_ctx, r_ctx, s_ctx, z_ctx[9:12]) if with_ctx else None
    return y_ctx, y_lat


def swiglu_ffn(h, w_up, w_down):
    a, b = jnp.split(h @ w_up, 2, axis=-1)
    return (jax.nn.silu(a) * b) @ w_down


def setup_inputs(seed: int = 0) -> dict:
    key = jax.random.key(seed)
    ks = jax.random.split(key, 32)
    f32 = jnp.float32
    L, G, P, C = DEPTH, SSM_GROUPS, SSM_STATE, SSM_GROUP

    def normal(k, shape, scale):
        return jax.random.normal(k, shape, f32) * scale

    def gain(k, shape):
        return 1.0 + normal(k, shape, 0.02)

    lam_im_base = jnp.pi * jnp.arange(P, dtype=f32)
    return {
        'x': normal(ks[0], (BATCH, SEQ, D_MODEL), 1.0),
        'c': normal(ks[1], (BATCH, D_MODEL), 1.0),
        'ctx': normal(ks[2], (BATCH, CTX_LEN, D_MODEL), 1.0),
        'c_ctx': normal(ks[3], (D_MODEL,), 1.0),
        'w_mod': normal(ks[4], (L, D_MODEL, ADALN_CHUNKS * D_MODEL), 0.5 * D_MODEL ** -0.5),
        'b_mod': normal(ks[5], (L, ADALN_CHUNKS * D_MODEL), 0.01),
        'norm1_g': gain(ks[6], (L, D_MODEL)),
        'norm2_g': gain(ks[7], (L, D_MODEL)),
        'w_in': normal(ks[8], (L, D_MODEL, N_IN), D_MODEL ** -0.5),
        'q_norm_g': gain(ks[9], (L, HEAD_DIM)),
        'k_norm_g': gain(ks[10], (L, HEAD_DIM)),
        'hgrn_lb': normal(ks[11], (L, 2, HG_WIDTH), 1.0),
        'hgrn_norm_g': gain(ks[12], (L, HG_DV)),
        'ssm_lam_re': -0.5 + normal(ks[13], (L, 2, G, P), 0.01),
        'ssm_lam_im': lam_im_base + normal(ks[14], (L, 2, G, P), 0.01),
        'ssm_log_dt': jax.random.uniform(ks[15], (L, 2, G), f32, math.log(1e-3), math.log(1e-1)),
        'ssm_b_re': normal(ks[16], (L, 2, G, P, C), (2 * C) ** -0.5),
        'ssm_b_im': normal(ks[17], (L, 2, G, P, C), (2 * C) ** -0.5),
        'ssm_c_re': normal(ks[18], (L, 2, G, C, P), P ** -0.5),
        'ssm_c_im': normal(ks[19], (L, 2, G, C, P), P ** -0.5),
        'ssm_d': normal(ks[20], (L, SSM_WIDTH), 1.0),
        'w_glu': normal(ks[21], (L, SSM_WIDTH, SSM_WIDTH), SSM_WIDTH ** -0.5),
        'b_glu': normal(ks[22], (L, SSM_WIDTH), 0.01),
        'w_br_attn': normal(ks[23], (L, ATT_WIDTH, D_MODEL), ATT_WIDTH ** -0.5),
        'w_br_hgrn': normal(ks[24], (L, HG_VWIDTH, D_MODEL), HG_VWIDTH ** -0.5),
        'w_br_ssm': normal(ks[25], (L, SSM_WIDTH, D_MODEL), SSM_WIDTH ** -0.5),
        'w_out': normal(ks[26], (L, D_MODEL, D_MODEL), D_MODEL ** -0.5),
        'w_ffn_up': normal(ks[27], (L, D_MODEL, 2 * FFN_HIDDEN), D_MODEL ** -0.5),
        'w_ffn_down': normal(ks[28], (L, FFN_HIDDEN, D_MODEL), FFN_HIDDEN ** -0.5),
    }


def reference(x, c, ctx, c_ctx, w_mod, b_mod, norm1_g, norm2_g, w_in, q_norm_g, k_norm_g, hgrn_lb, hgrn_norm_g,
              ssm_lam_re, ssm_lam_im, ssm_log_dt, ssm_b_re, ssm_b_im, ssm_c_re, ssm_c_im, ssm_d, w_glu, b_glu,
              w_br_attn, w_br_hgrn, w_br_ssm, w_out, w_ffn_up, w_ffn_down):
    rope = axial_rope_tables(x.shape[1])
    lb_soft = jax.nn.softmax(hgrn_lb.astype(jnp.float32), axis=0)
    lower_bounds = jnp.cumsum(lb_soft, axis=0) - lb_soft[0]
    cond_lat = jax.nn.silu(c)
    cond_ctx = jax.nn.silu(c_ctx)
    x_lat, x_ctx = x, ctx
    for l in range(DEPTH):
        with_ctx = l < DEPTH - 1
        sh1, sc1, g1, sh2, sc2, g2 = jnp.split((cond_lat @ w_mod[l] + b_mod[l])[:, None, :], ADALN_CHUNKS, axis=-1)
        csh1, csc1, cg1, csh2, csc2, cg2 = jnp.split(cond_ctx @ w_mod[l] + b_mod[l], ADALN_CHUNKS, axis=-1)
        p = {
            'w_in': w_in[l], 'q_norm_g': q_norm_g[l], 'k_norm_g': k_norm_g[l], 'hgrn_norm_g': hgrn_norm_g[l],
            'ssm_lam_re': ssm_lam_re[l], 'ssm_lam_im': ssm_lam_im[l], 'ssm_log_dt': ssm_log_dt[l],
            'ssm_b_re': ssm_b_re[l], 'ssm_b_im': ssm_b_im[l], 'ssm_c_re': ssm_c_re[l], 'ssm_c_im': ssm_c_im[l],
            'ssm_d': ssm_d[l], 'w_glu': w_glu[l], 'b_glu': b_glu[l],
            'w_br_attn': w_br_attn[l], 'w_br_hgrn': w_br_hgrn[l], 'w_br_ssm': w_br_ssm[l], 'w_out': w_out[l],
        }
        h_lat = modulate(x_lat, norm1_g[l], sh1, sc1)
        h_ctx = modulate(x_ctx, norm1_g[l], csh1, csc1)
        y_ctx, y_lat = mixer_sublayer(h_ctx, h_lat, p, lower_bounds[l], rope, with_ctx)
        x_lat = x_lat + g1 * y_lat
        x_lat = x_lat + g2 * swiglu_ffn(modulate(x_lat, norm2_g[l], sh2, sc2), w_ffn_up[l], w_ffn_down[l])
        if with_ctx:
            x_ctx = x_ctx + cg1 * y_ctx
            x_ctx = x_ctx + cg2 * swiglu_ffn(modulate(x_ctx, norm2_g[l], csh2, csc2), w_ffn_up[l], w_ffn_down[l])
    return x_lat
```

```cpp
#include <hip/hip_runtime.h>
#include <hip/hip_cooperative_groups.h>
#include <cstdio>
#include <cstdint>
__device__ __forceinline__ int lane_id_fresh() { int l; asm volatile("v_mbcnt_lo_u32_b32 %0, -1, 0\n\tv_mbcnt_hi_u32_b32 %0, -1, %0" : "=v"(l)); return l; }
namespace pg8 {
#define PG8_LAS __attribute__((address_space(3)))
typedef unsigned short bf16_t;
typedef short bf16x8 __attribute__((ext_vector_type(8)));
typedef float f32x4 __attribute__((ext_vector_type(4)));
typedef unsigned u32x4 __attribute__((ext_vector_type(4)));
constexpr int BM = 256, BK = 64, HALF = 128, HTB = HALF * BK * 2  , STAGE_BYTES = 8 * HTB, NXCD = 8, WGM = 8;

__host__ __device__ __forceinline__ int lds_byte(int r, int c) { const int st = (r >> 4) * 2 + (c >> 5), rr = r & 15, cc = c & 31, ob = rr * 64 + cc * 2; return st * 1024 + (ob ^ (((ob >> 9) & 1) << 5)); }
__host__ __device__ __forceinline__ void stage_rc(int b, int& R, int& C) { const int st = b / 1024, sb = b % 1024, swz = sb ^ (((sb >> 9) & 1) << 5); R = (st >> 1) * 16 + swz / 64; C = (st & 1) * 32 + (swz % 64) / 2; }
__host__ __device__ __forceinline__ int perm32(int rho) { const int n = rho >> 4, i = rho & 15; return 8 * (i >> 2) + 4 * n + (i & 3); }

struct Unit { int pm, pn; };
struct Gemm { const bf16_t* A; const bf16_t* Bt; int M, N, K; int lda, ldb; };

struct StaticOrder {
    int nM, nN, nwg, G, c;
    __host__ __device__ void init(int M, int N, int G_, int c_) { nM = M / BM; nN = N / BM; nwg = nM * nN; G = G_; c = c_; }
    __host__ __device__ bool next(int i, Unit& u) const {
        const long L = (long)i * G + c; if (L >= nwg) return false;
        int wgid = (int)L; { const int q = nwg / NXCD, r = nwg % NXCD, xcd = wgid % NXCD, off = wgid / NXCD; wgid = (xcd < r ? xcd * (q + 1) : r * (q + 1) + (xcd - r) * q) + off; }
        const int nig = WGM * nN, gid = wgid / nig, fm = gid * WGM, gsz = (nM - fm) < WGM ? (nM - fm) : WGM;
        u.pm = fm + ((wgid % nig) % gsz); u.pn = (wgid % nig) / gsz; return true;
    }
    __device__ __forceinline__ void a_ready(const Unit&) const {}
    __device__ __forceinline__ void done(const Unit&) const {}
};

__device__ __forceinline__ unsigned cvt_pk_bf16(float lo, float hi) { unsigned r; asm volatile("v_cvt_pk_bf16_f32 %0, %1, %2" : "=v"(r) : "v"(lo), "v"(hi)); return r; }
typedef float f32x2 __attribute__((ext_vector_type(2)));
__device__ __forceinline__ f32x2 gelu_pk(f32x2 v) {
    const f32x2 av = __builtin_elementwise_abs(v), d = av * 0.2316418882f + 1.0f;
    f32x2 t; t.x = __builtin_amdgcn_rcpf(d.x); t.y = __builtin_amdgcn_rcpf(d.y);
    f32x2 q = t * 0.5307027145f + (-0.7265760135f); q = q * t + 0.7107068705f; q = q * t + (-0.142248368f); q = q * t + 0.127414796f; q = q * t;
    const f32x2 s = (v * v) * (-0.72134752044f);
    f32x2 e; e.x = __builtin_amdgcn_exp2f(s.x); e.y = __builtin_amdgcn_exp2f(s.y);
    const f32x2 m = v * (q * e), r = v - m;
    f32x2 o; o.x = v.x < 0.f ? m.x : r.x; o.y = v.y < 0.f ? m.y : r.y; return o;
}

template <int ACT  > struct EpiBf16 {
    static constexpr bool PERM = true, AFTER_DRAIN = false; static_assert(ACT == 0 || ACT == 1, "EpiBf16: ACT is 0 (none) or 1 (gelu_pk)");
    bf16_t* O; int ldc; const float* bias; int split_cols; size_t split_stride; float scale0;
    __device__ __forceinline__ void operator()(const f32x4 (&acc)[2][2][4][2], const Unit& u, int wr, int wc, int fr, int fq) const {
        const int row0 = u.pm * BM + wr * 64 + fr; int colt = u.pn * BM; bf16_t* base = O;
        float sc = 1.f; if (split_cols) { const int t = colt / split_cols; base += (size_t)t * split_stride; colt -= t * split_cols; if (t == 0) sc = scale0; }
        const int col0 = colt + wc * 32 + 8 * fq, bcol0 = u.pn * BM + wc * 32 + 8 * fq;
        f32x4 bv[2][2];
#pragma unroll
        for (int bj = 0; bj < 2; ++bj)
#pragma unroll
            for (int n = 0; n < 2; ++n) bv[bj][n] = bias ? *(const f32x4*)(bias + bcol0 + bj * HALF + 4 * n) : (f32x4){0.f, 0.f, 0.f, 0.f};
#pragma unroll
        for (int ai = 0; ai < 2; ++ai)
#pragma unroll
            for (int m = 0; m < 4; ++m) { bf16_t* rowp = base + (size_t)(row0 + ai * HALF + m * 16) * ldc + col0;
#pragma unroll
                for (int bj = 0; bj < 2; ++bj) { f32x4 v0 = acc[ai][bj][m][0] + bv[bj][0], v1 = acc[ai][bj][m][1] + bv[bj][1];
                    if (ACT == 1) { f32x2 a = gelu_pk((f32x2){v0[0], v0[1]}), b = gelu_pk((f32x2){v0[2], v0[3]}), c = gelu_pk((f32x2){v1[0], v1[1]}), d = gelu_pk((f32x2){v1[2], v1[3]});
                        v0 = (f32x4){a.x, a.y, b.x, b.y}; v1 = (f32x4){c.x, c.y, d.x, d.y}; }
                    v0 = v0 * sc; v1 = v1 * sc; u32x4 w; w.x = cvt_pk_bf16(v0[0], v0[1]); w.y = cvt_pk_bf16(v0[2], v0[3]); w.z = cvt_pk_bf16(v1[0], v1[1]); w.w = cvt_pk_bf16(v1[2], v1[3]);
                    *(u32x4*)(rowp + bj * HALF) = w; } }
    }
};
__device__ __forceinline__ float bf2f_(unsigned short h) { return __uint_as_float(((unsigned)h) << 16); }
__device__ __forceinline__ float sigm_(float x) { return __builtin_amdgcn_rcpf(1.f + __expf(-x)); }
__device__ __forceinline__ void unpack8(const u32x4 w, float (&f)[8]) {
    f[0] = __uint_as_float(w.x << 16); f[1] = __uint_as_float(w.x & 0xffff0000u); f[2] = __uint_as_float(w.y << 16); f[3] = __uint_as_float(w.y & 0xffff0000u);
    f[4] = __uint_as_float(w.z << 16); f[5] = __uint_as_float(w.z & 0xffff0000u); f[6] = __uint_as_float(w.w << 16); f[7] = __uint_as_float(w.w & 0xffff0000u);
}
__device__ __forceinline__ u32x4 pack8(const float (&f)[8]) { u32x4 w; w.x = cvt_pk_bf16(f[0], f[1]); w.y = cvt_pk_bf16(f[2], f[3]); w.z = cvt_pk_bf16(f[4], f[5]); w.w = cvt_pk_bf16(f[6], f[7]); return w; }

struct MapOrder {
    StaticOrder so; int latonly;
    __device__ void init(int nMt, int N, int G_, int c_, int lo) { so.init(nMt * BM, N, G_, c_); latonly = lo; }
    __device__ bool next(int i, Unit& u) const { if (!so.next(i, u)) return false; if (latonly == 1) u.pm += 1 + (u.pm >= 64 ? 1 : 0); else if (latonly == 2) u.pm = u.pm ? 65 : 0; return true; }
    __device__ __forceinline__ void a_ready(const Unit&) const {}
    __device__ __forceinline__ void done(const Unit&) const {}
};

struct EpiRoute {
    static constexpr bool PERM = true, AFTER_DRAIN = false, HAS_MID = false;
    bf16_t *Zq, *Zkv, *Zh, *Zu, *Zg;
    __device__ __forceinline__ void operator()(const f32x4 (&acc)[2][2][4][2], const Unit& u, int wr, int wc, int fr, int fq) const {
        asm volatile("" : "+v"(fr), "+v"(fq));
        const int pn = u.pn; bf16_t* base; int ldc, colt;
        if (pn < 2) { base = Zq; ldc = 512; colt = pn * 256; } else if (pn == 2) { base = Zkv; ldc = 256; colt = 0; }
        else if (pn < 8) { base = Zh; ldc = 1280; colt = (pn - 3) * 256; } else if (pn == 8) { base = Zu; ldc = 256; colt = 0; }
        else { base = Zg; ldc = 3072; colt = (pn - 9) * 256; }
        const int row0 = u.pm * BM + wr * 64 + fr, col0 = colt + wc * 32 + 8 * fq;
#pragma unroll
        for (int ai = 0; ai < 2; ++ai)
#pragma unroll
            for (int m = 0; m < 4; ++m) { bf16_t* rowp = base + (size_t)(row0 + ai * HALF + m * 16) * ldc + col0;
#pragma unroll
                for (int bj = 0; bj < 2; ++bj) { const f32x4 v0 = acc[ai][bj][m][0], v1 = acc[ai][bj][m][1];
                    u32x4 w; w.x = cvt_pk_bf16(v0[0], v0[1]); w.y = cvt_pk_bf16(v0[2], v0[3]); w.z = cvt_pk_bf16(v1[0], v1[1]); w.w = cvt_pk_bf16(v1[2], v1[3]);
                    *(u32x4*)(rowp + bj * HALF) = w; } }
    }
};
struct EpiGlu {
    static constexpr bool PERM = true, AFTER_DRAIN = false, HAS_MID = false;
    bf16_t* Ys; const float* bglu; int ld;
    __device__ __forceinline__ void operator()(const f32x4 (&acc)[2][2][4][2], const Unit& u, int wr, int wc, int fr, int fq) const {
        asm volatile("" : "+v"(fr), "+v"(fq));
        const int row0 = u.pm * BM + wr * 64 + fr, col0 = wc * 32 + 8 * fq;
        f32x4 b4[2][2];
#pragma unroll
        for (int bj = 0; bj < 2; ++bj) { b4[bj][0] = *(const f32x4*)(bglu + col0 + bj * HALF); b4[bj][1] = *(const f32x4*)(bglu + col0 + bj * HALF + 4); }
#pragma unroll
        for (int ai = 0; ai < 2; ++ai)
#pragma unroll
            for (int mh = 0; mh < 2; ++mh) { u32x4 zr[2][2];
#pragma unroll
                for (int mm = 0; mm < 2; ++mm)
#pragma unroll
                    for (int bj = 0; bj < 2; ++bj) zr[mm][bj] = *(const u32x4*)(Ys + (size_t)(row0 + ai * HALF + (2 * mh + mm) * 16) * ld + col0 + bj * HALF);
#pragma unroll
                for (int mm = 0; mm < 2; ++mm)
#pragma unroll
                    for (int bj = 0; bj < 2; ++bj) { const int m = 2 * mh + mm; float z[8], o[8]; unpack8(zr[mm][bj], z);
                        const f32x4 v0 = acc[ai][bj][m][0] + b4[bj][0], v1 = acc[ai][bj][m][1] + b4[bj][1];
#pragma unroll
                        for (int i = 0; i < 4; ++i) { o[i] = z[i] * sigm_(v0[i]); o[4 + i] = z[4 + i] * sigm_(v1[i]); }
                        *(u32x4*)(Ys + (size_t)(row0 + ai * HALF + m * 16) * ld + col0 + bj * HALF) = pack8(o); } }
    }
};
template <bool FIRST> struct EpiMerge {
    static constexpr bool PERM = true, AFTER_DRAIN = false, HAS_MID = false;
    bf16_t* m16; const bf16_t* Zg; int gcol;
    __device__ __forceinline__ void operator()(const f32x4 (&acc)[2][2][4][2], const Unit& u, int wr, int wc, int fr, int fq) const {
        asm volatile("" : "+v"(fr), "+v"(fq));
        const int row0 = u.pm * BM + wr * 64 + fr, col0 = u.pn * BM + wc * 32 + 8 * fq;
#pragma unroll
        for (int ai = 0; ai < 2; ++ai)
#pragma unroll
            for (int mh = 0; mh < 2; ++mh) { u32x4 gr[2][2], orr[2][2];
#pragma unroll
                for (int mm = 0; mm < 2; ++mm)
#pragma unroll
                    for (int bj = 0; bj < 2; ++bj) { const size_t r = (size_t)(row0 + ai * HALF + (2 * mh + mm) * 16); const int c = col0 + bj * HALF;
                        gr[mm][bj] = *(const u32x4*)(Zg + r * 3072 + gcol + c); if (!FIRST) orr[mm][bj] = *(const u32x4*)(m16 + r * 1024 + c); }
#pragma unroll
                for (int mm = 0; mm < 2; ++mm)
#pragma unroll
                    for (int bj = 0; bj < 2; ++bj) { const int m = 2 * mh + mm; const size_t r = (size_t)(row0 + ai * HALF + m * 16); const int c = col0 + bj * HALF; float g[8], o[8];
                        unpack8(gr[mm][bj], g);
                        if (FIRST) {
#pragma unroll
                            for (int i = 0; i < 8; ++i) o[i] = 0.f; } else unpack8(orr[mm][bj], o);
                        const f32x4 v0 = acc[ai][bj][m][0], v1 = acc[ai][bj][m][1];
#pragma unroll
                        for (int i = 0; i < 4; ++i) { o[i] += sigm_(g[i]) * v0[i]; o[4 + i] += sigm_(g[4 + i]) * v1[i]; }
                        *(u32x4*)(m16 + r * 1024 + c) = pack8(o); } }
    }
};
struct EpiMerge3 {
    static constexpr bool PERM = true, AFTER_DRAIN = false, HAS_MID = true; static constexpr int MID1 = 8, MID2 = 12;
    bf16_t* m16; const bf16_t* Zg;
    __device__ __forceinline__ void mid(f32x4 (&acc)[2][2][4][2], const Unit& u, int wr, int wc, int fr, int fq, int t) const {
        asm volatile("" : "+v"(fr), "+v"(fq));
        const int gn = (t == MID1) ? 0 : 1024, gd = gn + 1024;
        const int row0 = u.pm * BM + wr * 64 + fr, col0 = u.pn * BM + wc * 32 + 8 * fq;
#pragma unroll
        for (int ai = 0; ai < 2; ++ai)
#pragma unroll
            for (int mh = 0; mh < 1; ++mh) { u32x4 an[4][2], ad[4][2];
#pragma unroll
                for (int mm = 0; mm < 4; ++mm)
#pragma unroll
                    for (int bj = 0; bj < 2; ++bj) { const size_t r = (size_t)(row0 + ai * HALF + (mm) * 16); const int c = col0 + bj * HALF;
                        an[mm][bj] = *(const u32x4*)(Zg + r * 3072 + gn + c); ad[mm][bj] = *(const u32x4*)(Zg + r * 3072 + gd + c); }
#pragma unroll
                for (int mm = 0; mm < 4; ++mm)
#pragma unroll
                    for (int bj = 0; bj < 2; ++bj) { const int m = mm; float a[8], d[8]; unpack8(an[mm][bj], a); unpack8(ad[mm][bj], d);
#pragma unroll
                        for (int i = 0; i < 4; ++i) {
                            acc[ai][bj][m][0][i] *= (1.f + __expf(fminf(-d[i], 80.f))) * __builtin_amdgcn_rcpf(1.f + __expf(fminf(-a[i], 80.f)));
                            acc[ai][bj][m][1][i] *= (1.f + __expf(fminf(-d[4 + i], 80.f))) * __builtin_amdgcn_rcpf(1.f + __expf(fminf(-a[4 + i], 80.f))); } } }
    }
    __device__ __forceinline__ void operator()(const f32x4 (&acc)[2][2][4][2], const Unit& u, int wr, int wc, int fr, int fq) const {
        asm volatile("" : "+v"(fr), "+v"(fq));
        const int row0 = u.pm * BM + wr * 64 + fr, col0 = u.pn * BM + wc * 32 + 8 * fq;
        u32x4 gr[2][4][2];
#pragma unroll
        for (int ai = 0; ai < 2; ++ai)
#pragma unroll
            for (int m = 0; m < 4; ++m)
#pragma unroll
                for (int bj = 0; bj < 2; ++bj) gr[ai][m][bj] = *(const u32x4*)(Zg + (size_t)(row0 + ai * HALF + m * 16) * 3072 + 2048 + col0 + bj * HALF);
#pragma unroll
        for (int ai = 0; ai < 2; ++ai)
#pragma unroll
            for (int m = 0; m < 4; ++m)
#pragma unroll
                for (int bj = 0; bj < 2; ++bj) { float g[8], o[8]; unpack8(gr[ai][m][bj], g); const f32x4 v0 = acc[ai][bj][m][0], v1 = acc[ai][bj][m][1];
#pragma unroll
                    for (int i = 0; i < 4; ++i) { o[i] = sigm_(g[i]) * v0[i]; o[4 + i] = sigm_(g[4 + i]) * v1[i]; }
                    *(u32x4*)(m16 + (size_t)(row0 + ai * HALF + m * 16) * 1024 + col0 + bj * HALF) = pack8(o); }
    }
};
struct EpiResid {
    static constexpr bool PERM = false, AFTER_DRAIN = false, HAS_MID = false;
    const float *src_lat, *src_ctx; float *dst_lat, *dst_ctx; const float* gate;
    __device__ __forceinline__ void operator()(const f32x4 (&acc)[2][2][4][2], const Unit& u, int wr, int wc, int fr, int fq) const {
        asm volatile("" : "+v"(fr), "+v"(fq));
        const int b = u.pm / 65, pt = u.pm % 65; const float* s; float* d; int v;
        if (pt == 0) { s = src_ctx + (size_t)b * 256 * 1024; d = dst_ctx + (size_t)b * 256 * 1024; v = 2; }
        else { const size_t o = ((size_t)b * 16384 + (size_t)(pt - 1) * 256) * 1024; s = src_lat + o; d = dst_lat + o; v = b; }
        const float* gv = gate + v * 6144; const int col0 = u.pn * BM + wc * 32 + 4 * fq;
        f32x4 g4[2][2];
#pragma unroll
        for (int bj = 0; bj < 2; ++bj)
#pragma unroll
            for (int n = 0; n < 2; ++n) g4[bj][n] = *(const f32x4*)(gv + col0 + bj * HALF + n * 16);
#pragma unroll
        for (int ai = 0; ai < 2; ++ai)
#pragma unroll
            for (int mh = 0; mh < 2; ++mh) { f32x4 x[2][2][2];
#pragma unroll
                for (int mm = 0; mm < 2; ++mm)
#pragma unroll
                    for (int bj = 0; bj < 2; ++bj)
#pragma unroll
                        for (int n = 0; n < 2; ++n) x[mm][bj][n] = *(const f32x4*)(s + (size_t)(ai * HALF + wr * 64 + (2 * mh + mm) * 16 + fr) * 1024 + col0 + bj * HALF + n * 16);
#pragma unroll
                for (int mm = 0; mm < 2; ++mm)
#pragma unroll
                    for (int bj = 0; bj < 2; ++bj)
#pragma unroll
                        for (int n = 0; n < 2; ++n) *(f32x4*)(d + (size_t)(ai * HALF + wr * 64 + (2 * mh + mm) * 16 + fr) * 1024 + col0 + bj * HALF + n * 16) = x[mm][bj][n] + g4[bj][n] * acc[ai][bj][2 * mh + mm][n]; }
    }
};
struct EpiPart {
    static constexpr bool PERM = false, AFTER_DRAIN = false, HAS_MID = false;
    float* P; const float* gate;
    __device__ __forceinline__ void operator()(const f32x4 (&acc)[2][2][4][2], const Unit& u, int wr, int wc, int fr, int fq) const {
        asm volatile("" : "+v"(fr), "+v"(fq));
        float* d = P + (size_t)(u.pm ? 256 : 0) * 1024; const int col0 = u.pn * BM + wc * 32 + 4 * fq;
#pragma unroll
        for (int bj = 0; bj < 2; ++bj)
#pragma unroll
            for (int n = 0; n < 2; ++n) { const f32x4 g4 = *(const f32x4*)(gate + col0 + bj * HALF + n * 16);
#pragma unroll
                for (int ai = 0; ai < 2; ++ai)
#pragma unroll
                    for (int m = 0; m < 4; ++m) *(f32x4*)(d + (size_t)(ai * HALF + wr * 64 + m * 16 + fr) * 1024 + col0 + bj * HALF + n * 16) = g4 * acc[ai][bj][m][n]; }
    }
};
struct EpiSwiglu {
    static constexpr bool PERM = true, AFTER_DRAIN = false, HAS_MID = false;
    bf16_t* Hid;
    __device__ __forceinline__ void operator()(const f32x4 (&acc)[2][2][4][2], const Unit& u, int wr, int wc, int fr, int fq) const {
        asm volatile("" : "+v"(fr), "+v"(fq));
        const int row0 = u.pm * BM + wr * 64 + fr, col0 = u.pn * HALF + wc * 32 + 8 * fq;
#pragma unroll
        for (int ai = 0; ai < 2; ++ai)
#pragma unroll
            for (int m = 0; m < 4; ++m) { float o[8]; const f32x4 a0 = acc[ai][0][m][0], a1 = acc[ai][0][m][1], b0 = acc[ai][1][m][0], b1 = acc[ai][1][m][1];
#pragma unroll
                for (int i = 0; i < 4; ++i) { o[i] = a0[i] * sigm_(a0[i]) * b0[i]; o[4 + i] = a1[i] * sigm_(a1[i]) * b1[i]; }
                *(u32x4*)(Hid + (size_t)(row0 + ai * HALF + m * 16) * 2816 + col0) = pack8(o); }
    }
};
template <class Epi, class Sched, bool ALIGN_EPI = false, bool SP2 = false>
__device__ __forceinline__ void gemm_phase(PG8_LAS unsigned char* lds, const Gemm g, const Sched& S, const Epi& E, int wave_in) {
    int lane_ = lane_id_fresh(); asm volatile("" : "+s"(wave_in));
    const int tid = wave_in * 64 + lane_, wid = __builtin_amdgcn_readfirstlane(tid >> 6), lane = tid & 63, wr = wid >> 2, wc = wid & 3, fr = lane & 15, fq = lane >> 4;
    const int K = g.K, nt = K / BK, lda_ = g.lda ? g.lda : g.K, ldb_ = g.ldb ? g.ldb : g.K;
    unsigned voffA[2], voffB[2];
#pragma unroll
    for (int i = 0; i < 2; ++i) { int R, C; stage_rc(tid * 16 + i * 8192, R, C); const int Rb = Epi::PERM ? ((R & ~31) + perm32(R & 31)) : R;
        voffA[i] = (unsigned)(R * lda_ + C) * 2u; voffB[i] = (unsigned)(Rb * ldb_ + C) * 2u; }
    const size_t kstep = (size_t)(BK * 2);
    const size_t hstep = (size_t)HALF * ldb_ * 2;
    const size_t tstep = 2 * hstep;
    const size_t hstepA = (size_t)HALF * lda_ * 2, tstepA = 2 * hstepA;
    const unsigned ldsw = (unsigned)wid * 1024u;
    const int aoff = lds_byte(wr * 64 + fr, fq * 8), boff = lds_byte(wc * 32 + fr, fq * 8);
#define PG8_SA(b, h) (((b) * 2 + (h)) * HTB)
#define PG8_SB(b, h) ((4 + (b) * 2 + (h)) * HTB)
#define PG8_STAGE(bufoff, gbase, voff) do { _Pragma("unroll") for (int _i = 0; _i < 2; ++_i) \
        __builtin_amdgcn_global_load_lds((const unsigned*)((const char*)(gbase) + (voff)[_i]), (PG8_LAS unsigned*)(lds + (bufoff) + ldsw + _i * 8192), 16, 0, 0); } while (0)
#define PG8_LDA(dst, b, h) do { _Pragma("unroll") for (int m = 0; m < 4; ++m) _Pragma("unroll") for (int k = 0; k < 2; ++k) dst[m][k] = *(const PG8_LAS bf16x8*)(lds + PG8_SA(b, h) + aoff + m * 2048 + k * 1024); } while (0)
#define PG8_LDB(dst, b, h) do { _Pragma("unroll") for (int n = 0; n < 2; ++n) _Pragma("unroll") for (int k = 0; k < 2; ++k) dst[n][k] = *(const PG8_LAS bf16x8*)(lds + PG8_SB(b, h) + boff + n * 2048 + k * 1024); } while (0)
#define PG8_MMA(ai, bj, At, Bt) do { __builtin_amdgcn_s_setprio(1); _Pragma("unroll") for (int m = 0; m < 4; ++m) _Pragma("unroll") for (int n = 0; n < 2; ++n) _Pragma("unroll") for (int k = 0; k < 2; ++k) \
        acc[ai][bj][m][n] = __builtin_amdgcn_mfma_f32_16x16x32_bf16(Bt[n][k], At[m][k], acc[ai][bj][m][n], 0, 0, 0); __builtin_amdgcn_s_setprio(0); } while (0)
#define PG8_WAIT_V(n) asm volatile("s_waitcnt vmcnt(" #n ")" ::: "memory")
#define PG8_WAIT_L(n) asm volatile("s_waitcnt lgkmcnt(" #n ")" ::: "memory")
#define PG8_BAR __builtin_amdgcn_s_barrier()
#define PG8_SCHED __builtin_amdgcn_sched_barrier(0)
    Unit cur, nxt; int ui = 0;
    if (!S.next(0, cur)) return;
    f32x4 acc[2][2][4][2];
#pragma unroll
    for (int a = 0; a < 2; ++a)
#pragma unroll
        for (int b = 0; b < 2; ++b)
#pragma unroll
            for (int m = 0; m < 4; ++m)
#pragma unroll
                for (int n = 0; n < 2; ++n) acc[a][b][m][n] = (f32x4){0.f, 0.f, 0.f, 0.f};
    bf16x8 At[4][2], B0[2][2], B1[2][2];
    const char* cA = (const char*)g.A + (size_t)cur.pm * tstepA; const char* cB = (const char*)g.Bt + (size_t)cur.pn * tstep;
    S.a_ready(cur);
    if constexpr (SP2) {
        PG8_STAGE(PG8_SB(0, 0), cB, voffB); PG8_STAGE(PG8_SB(0, 1), cB + hstep, voffB); PG8_STAGE(PG8_SA(0, 0), cA, voffA); PG8_STAGE(PG8_SA(0, 1), cA + hstepA, voffA);
        if (wr == 1) PG8_BAR;
        PG8_WAIT_V(2); PG8_BAR;
        PG8_STAGE(PG8_SB(1, 0), cB + kstep, voffB); PG8_STAGE(PG8_SA(1, 0), cA + kstep, voffA); PG8_STAGE(PG8_SB(1, 1), cB + hstep + kstep, voffB);
        PG8_WAIT_V(6); PG8_BAR;
    } else {
        PG8_STAGE(PG8_SB(0, 0), cB, voffB); PG8_STAGE(PG8_SA(0, 0), cA, voffA); PG8_STAGE(PG8_SB(0, 1), cB + hstep, voffB); PG8_STAGE(PG8_SA(0, 1), cA + hstepA, voffA);
        if (wr == 1) PG8_BAR;
        PG8_WAIT_V(4); PG8_BAR;
        PG8_STAGE(PG8_SB(1, 0), cB + kstep, voffB); PG8_STAGE(PG8_SA(1, 0), cA + kstep, voffA); PG8_STAGE(PG8_SB(1, 1), cB + hstep + kstep, voffB);
        PG8_WAIT_V(6); PG8_BAR;
    }
    for (;;) {
        const bool has_next = S.next(ui + 1, nxt);
        const char* nA = has_next ? (const char*)g.A + (size_t)nxt.pm * tstepA : cA; const char* nB = has_next ? (const char*)g.Bt + (size_t)nxt.pn * tstep : cB;
        for (int t = 0; t < nt; t += 2) {
            if constexpr (Epi::HAS_MID) { if (t == Epi::MID1 || t == Epi::MID2) E.mid(acc, cur, wr, wc, fr, fq, t); }
            const bool last = (t == nt - 2);
            const char* a1 = cA + (size_t)(t + 1) * kstep;
            const char* a2 = last ? nA : cA + (size_t)(t + 2) * kstep; const char* b2 = last ? nB : cB + (size_t)(t + 2) * kstep;
            const char* a3 = a2 + kstep; const char* b3 = b2 + kstep;
            if (last && has_next) S.a_ready(nxt);
            if constexpr (SP2) {
            PG8_LDB(B0, 0, 0); PG8_LDB(B1, 0, 1); PG8_SCHED; PG8_LDA(At, 0, 0); PG8_STAGE(PG8_SA(1, 1), a1 + hstepA, voffA);
            PG8_WAIT_V(8); PG8_WAIT_L(0); PG8_BAR; PG8_MMA(0, 0, At, B0); PG8_MMA(0, 1, At, B1); PG8_BAR; PG8_SCHED;
            PG8_LDA(At, 0, 1); PG8_STAGE(PG8_SB(0, 0), b2, voffB); PG8_STAGE(PG8_SB(0, 1), b2 + hstep, voffB); PG8_STAGE(PG8_SA(0, 0), a2, voffA);
            PG8_WAIT_V(8); PG8_WAIT_L(0); PG8_BAR; PG8_MMA(1, 0, At, B0); PG8_MMA(1, 1, At, B1); PG8_BAR; PG8_SCHED;
            PG8_LDB(B0, 1, 0); PG8_LDB(B1, 1, 1); PG8_SCHED; PG8_LDA(At, 1, 0); PG8_STAGE(PG8_SA(0, 1), a2 + hstepA, voffA);
            PG8_WAIT_V(8); PG8_WAIT_L(0); PG8_BAR; PG8_MMA(0, 0, At, B0); PG8_MMA(0, 1, At, B1); PG8_BAR; PG8_SCHED;
            PG8_LDA(At, 1, 1); PG8_STAGE(PG8_SB(1, 0), b3, voffB); PG8_STAGE(PG8_SB(1, 1), b3 + hstep, voffB); PG8_STAGE(PG8_SA(1, 0), a3, voffA);
            PG8_WAIT_V(8); PG8_WAIT_L(0); PG8_BAR; PG8_MMA(1, 0, At, B0); PG8_MMA(1, 1, At, B1); PG8_BAR; PG8_SCHED;
            } else {
            PG8_LDB(B0, 0, 0); PG8_SCHED; PG8_LDA(At, 0, 0); PG8_STAGE(PG8_SA(1, 1), a1 + hstepA, voffA);
            PG8_WAIT_L(8); PG8_BAR; PG8_WAIT_L(0); PG8_MMA(0, 0, At, B0); PG8_BAR; PG8_SCHED;
            PG8_LDB(B1, 0, 1); PG8_STAGE(PG8_SB(0, 0), b2, voffB);
            PG8_BAR; PG8_WAIT_L(0); PG8_MMA(0, 1, At, B1); PG8_BAR;
            PG8_LDA(At, 0, 1); PG8_STAGE(PG8_SA(0, 0), a2, voffA);
            PG8_BAR; PG8_WAIT_L(0); PG8_MMA(1, 0, At, B0); PG8_BAR; PG8_SCHED;
            PG8_STAGE(PG8_SB(0, 1), b2 + hstep, voffB);
            PG8_WAIT_V(6); PG8_BAR; PG8_MMA(1, 1, At, B1); PG8_BAR;
            PG8_LDB(B0, 1, 0); PG8_SCHED; PG8_LDA(At, 1, 0); PG8_STAGE(PG8_SA(0, 1), a2 + hstepA, voffA);
            PG8_WAIT_L(8); PG8_BAR; PG8_WAIT_L(0); PG8_MMA(0, 0, At, B0); PG8_BAR; PG8_SCHED;
            PG8_LDB(B1, 1, 1); PG8_STAGE(PG8_SB(1, 0), b3, voffB);
            PG8_BAR; PG8_WAIT_L(0); PG8_MMA(0, 1, At, B1); PG8_BAR;
            PG8_LDA(At, 1, 1); PG8_STAGE(PG8_SA(1, 0), a3, voffA);
            PG8_BAR; PG8_WAIT_L(0); PG8_MMA(1, 0, At, B0); PG8_BAR; PG8_SCHED;
            PG8_STAGE(PG8_SB(1, 1), b3 + hstep, voffB);
            PG8_WAIT_V(6); PG8_BAR; PG8_MMA(1, 1, At, B1); PG8_BAR;
            }
        }
        if constexpr (ALIGN_EPI) { if (wr == 0) PG8_BAR; }
        if constexpr (!Epi::AFTER_DRAIN) { E(acc, cur, wr, wc, fr, fq); S.done(cur); }
        if (!has_next) break;
#pragma unroll
        for (int a = 0; a < 2; ++a)
#pragma unroll
            for (int b = 0; b < 2; ++b)
#pragma unroll
                for (int m = 0; m < 4; ++m)
#pragma unroll
                    for (int n = 0; n < 2; ++n) acc[a][b][m][n] = (f32x4){0.f, 0.f, 0.f, 0.f};
        cur = nxt; cA = nA; cB = nB; ++ui;
        if constexpr (ALIGN_EPI) { if (wr == 1) PG8_BAR; }
    }
    PG8_WAIT_V(0);
    if constexpr (!ALIGN_EPI) { if (wr == 0) PG8_BAR; }
    PG8_BAR;
    if constexpr (Epi::AFTER_DRAIN) { E.fused(acc, cur, wr, wc, fr, fq, lds, wid, lane); S.done(cur); }
#undef PG8_SA
#undef PG8_SB
#undef PG8_STAGE
#undef PG8_LDA
#undef PG8_LDB
#undef PG8_MMA
#undef PG8_WAIT_V
#undef PG8_WAIT_L
#undef PG8_BAR
#undef PG8_SCHED
}
}
#include <hip/hip_bf16.h>
#include <cmath>
namespace attn_body {
using bf16=__hip_bfloat16;
using bf16x8=__attribute__((ext_vector_type(8)))short;
using s16x4=__attribute__((ext_vector_type(4)))short;
using f32x16=__attribute__((ext_vector_type(16)))float;
using u32x4=__attribute__((ext_vector_type(4)))unsigned;
constexpr int D=64,QP=512,KP=256,OP=1024;
constexpr int NW=8,QBLK=32,QB=QBLK*NW,KVBLK=64;
constexpr int ATTN_UNIT_ROWS=QB;
__device__ __forceinline__ int crow(int r,int hi){return (r&3)+8*(r>>2)+4*hi;}
#define SBAR() __builtin_amdgcn_sched_barrier(0)
__device__ __forceinline__ void cmask(f32x16&p0,f32x16&p1,int jb,int qrel,int hi){
  const float NEG=-INFINITY; int kb=64*jb+4*hi;
  #pragma unroll
  for(int r=0;r<16;++r){int kv=kb+(r&3)+8*(r>>2); if(kv>qrel)p0[r]=NEG; if(kv+32>qrel)p1[r]=NEG;}
}

constexpr int NSLOT=3, SLOTB=8192;
constexpr int LDS_K=0, LDS_V=NSLOT*SLOTB, LDS_WS=2*NSLOT*SLOTB, LDS_OST=LDS_WS+NW*64*4, LDS_BYTES=LDS_OST+NW*4096;
constexpr float C2=0.125f*1.4426950408889634f;
__device__ __forceinline__ void glds16(const void*gsrc,unsigned lds_dst){unsigned keep;
  asm volatile("s_mov_b32 %0, m0\n\ts_mov_b32 m0, %2\n\ts_nop 0\n\tglobal_load_lds_dwordx4 %1, off\n\ts_mov_b32 m0, %0":"=&s"(keep):"v"(gsrc),"s"(lds_dst):"memory");}
__device__ __forceinline__ float max3f(float a,float b,float c){float r;asm("v_max3_f32 %0, %1, %2, %3":"=v"(r):"v"(a),"v"(b),"v"(c));return r;}
__device__ __forceinline__ float max2f(float a,float b){float r;asm("v_max_f32_e32 %0, %1, %2":"=v"(r):"v"(a),"v"(b));return r;}
__device__ __forceinline__ float fadd_s(float a,float b){float r;asm("v_add_f32_e32 %0, %1, %2":"=v"(r):"v"(a),"v"(b));return r;}
__device__ __forceinline__ float fsub_s(float a,float b){float r;asm("v_sub_f32_e32 %0, %1, %2":"=v"(r):"v"(a),"v"(b));return r;}
typedef float f32x2_t __attribute__((ext_vector_type(2))); typedef __bf16 bf16x2_t __attribute__((ext_vector_type(2)));
__device__ __forceinline__ unsigned cvtpk_s(float lo,float hi){f32x2_t v={lo,hi};bf16x2_t b=__builtin_convertvector(v,bf16x2_t);return __builtin_bit_cast(unsigned,b);}
#define WAIT_BAR(N) asm volatile("s_waitcnt vmcnt(" #N ") lgkmcnt(0)\n\ts_barrier":::"memory")

__device__ __forceinline__ void qkt(f32x16&p0,f32x16&p1,const char*Kslot,const bf16x8*qr,const f32x16&negm,int r32,int hi){
  const char*kb=Kslot+hi*1024+r32*16;
  #pragma unroll
  for(int d0=0;d0<4;++d0){
    const bf16x8 b0=*reinterpret_cast<const bf16x8*>(kb+d0*2048);
    const bf16x8 b1=*reinterpret_cast<const bf16x8*>(kb+d0*2048+512);
    if(d0==0){p0=__builtin_amdgcn_mfma_f32_32x32x16_bf16(b0,qr[0],negm,0,0,0);p1=__builtin_amdgcn_mfma_f32_32x32x16_bf16(b1,qr[0],negm,0,0,0);}
    else{p0=__builtin_amdgcn_mfma_f32_32x32x16_bf16(b0,qr[d0],p0,0,0,0);p1=__builtin_amdgcn_mfma_f32_32x32x16_bf16(b1,qr[d0],p1,0,0,0);}}
}
typedef __attribute__((address_space(3))) const char* lds_cptr;
typedef short v4i16_t __attribute__((ext_vector_type(4)));
__device__ __forceinline__ void kload8(bf16x8*kf,lds_cptr kp){
  kf[0]=*(const __attribute__((address_space(3))) bf16x8*)(kp);      kf[1]=*(const __attribute__((address_space(3))) bf16x8*)(kp+512);
  kf[2]=*(const __attribute__((address_space(3))) bf16x8*)(kp+2048); kf[3]=*(const __attribute__((address_space(3))) bf16x8*)(kp+2560);
  kf[4]=*(const __attribute__((address_space(3))) bf16x8*)(kp+4096); kf[5]=*(const __attribute__((address_space(3))) bf16x8*)(kp+4608);
  kf[6]=*(const __attribute__((address_space(3))) bf16x8*)(kp+6144); kf[7]=*(const __attribute__((address_space(3))) bf16x8*)(kp+6656);
}
__device__ __forceinline__ void kload2(bf16x8*kf,lds_cptr kp,int j){ kf[2*j]=*(const __attribute__((address_space(3))) bf16x8*)(kp+j*2048); kf[2*j+1]=*(const __attribute__((address_space(3))) bf16x8*)(kp+j*2048+512); }
__device__ __forceinline__ s16x4 vtr(lds_cptr p){ return __builtin_bit_cast(s16x4,__builtin_amdgcn_ds_read_tr16_b64_v4i16((__attribute__((address_space(3))) v4i16_t*)p)); }
__device__ __forceinline__ float rowmax(const f32x16&p0,const f32x16&p1){
  float a=max3f(p0[0],p0[1],p1[0]),b=max3f(p0[2],p0[3],p1[1]);a=max3f(a,p1[2],p1[3]);
  #pragma unroll
  for(int r=4;r<16;r+=4){a=max3f(a,p0[r],p0[r+1]);b=max3f(b,p0[r+2],p0[r+3]);a=max3f(a,p1[r],p1[r+1]);b=max3f(b,p1[r+2],p1[r+3]);}
  const float m=max2f(a,b);
  auto rr=__builtin_amdgcn_permlane32_swap(__float_as_uint(m),__float_as_uint(m),false,false);
  return max2f(__uint_as_float(rr[0]),__uint_as_float(rr[1]));
}
__device__ __forceinline__ void pv(f32x16*o,int vb,bf16x8 pa0,bf16x8 pa1,bf16x8 pa2,bf16x8 pa3){
  #pragma unroll
  for(int d0=0;d0<2;++d0){s16x4 lo[4],hi[4];
    #pragma unroll
    for(int ks=0;ks<4;++ks){
      asm volatile("ds_read_b64_tr_b16 %0,%1 offset:%c2":"=&v"(lo[ks]):"v"(vb),"i"(d0*4096+ks*1024):"memory");
      asm volatile("ds_read_b64_tr_b16 %0,%1 offset:%c2":"=&v"(hi[ks]):"v"(vb),"i"(d0*4096+ks*1024+512):"memory");}
    asm volatile("s_waitcnt lgkmcnt(0)":::"memory");SBAR();
    #define PK(k) (bf16x8){lo[k][0],lo[k][1],lo[k][2],lo[k][3],hi[k][0],hi[k][1],hi[k][2],hi[k][3]}
    o[d0]=__builtin_amdgcn_mfma_f32_32x32x16_bf16(pa0,PK(0),o[d0],0,0,0);
    o[d0]=__builtin_amdgcn_mfma_f32_32x32x16_bf16(pa1,PK(1),o[d0],0,0,0);
    o[d0]=__builtin_amdgcn_mfma_f32_32x32x16_bf16(pa2,PK(2),o[d0],0,0,0);
    o[d0]=__builtin_amdgcn_mfma_f32_32x32x16_bf16(pa3,PK(3),o[d0],0,0,0);
    #undef PK
  }
}

#ifndef ATTN_STORE16
#define ATTN_STORE16(p,v) (*(u32x4*)(p)=(v))
#endif
template<int THRL,bool FIXM> __device__ __forceinline__ void attn_unit(float mfix,long rowbase,int q0,int NT,int h,int hk,const bf16*Q,const bf16*__restrict__ K,const bf16*__restrict__ V,bf16*O,char*shm,int tid_in){
  int lane_=lane_id_fresh(); asm volatile("":"+s"(tid_in)); const int tid=tid_in*64+lane_,lane=tid&63,r32=lane&31,hi=lane>>5; const int wid=__builtin_amdgcn_readfirstlane(tid>>6);
  const bf16*Qw=Q+(rowbase+q0+wid*QBLK)*QP+h*D;
  const bf16*Kh=K+rowbase*KP+hk*D,*Vh=V+rowbase*KP+hk*D;
  const unsigned lds0=(unsigned)(uintptr_t)shm;
  float*wsf=(float*)(shm+LDS_WS)+wid*64;
  const bf16*ksrc=Kh+(long)lane*KP+wid*8;
  const bf16*vsrc=Vh+(long)(16*(wid&3)+(lane>>2))*KP+(wid>>2)*32+(lane&3)*8;
  const unsigned kdst=lds0+LDS_K+wid*1024, vdst=lds0+LDS_V+wid*1024;
  #define DMA_K(t,slot) glds16(ksrc+(long)(t)*KVBLK*KP,(unsigned)__builtin_amdgcn_readfirstlane(kdst+(slot)))
  #define DMA_V(t,slot) glds16(vsrc+(long)(t)*KVBLK*KP,(unsigned)__builtin_amdgcn_readfirstlane(vdst+(slot)))
  const int vb0=(int)(lds0+LDS_V)+((lane>>4)&1)*32+(lane&3)*8+(4*hi+((lane&15)>>2))*64;
  const char*Kbase=shm+LDS_K; bf16x8 kf[8];
  const lds_cptr shm3=(lds_cptr)shm; const lds_cptr kp0=shm3+LDS_K+hi*1024+r32*16; const lds_cptr vp0=shm3+LDS_V+((lane>>4)&1)*32+(lane&3)*8+(4*hi+((lane&15)>>2))*64;
  DMA_K(0,0);DMA_V(0,0);DMA_K(1,SLOTB);
  bf16x8 qr[4];
  #pragma unroll
  for(int d0=0;d0<4;++d0)qr[d0]=*reinterpret_cast<const bf16x8*>(&Qw[(long)r32*QP+d0*16+hi*8]);
  float mhat=0.f,l_reg=0.f;f32x16 o[2];o[0]=f32x16{};o[1]=f32x16{};f32x16 negm=f32x16{};asm volatile("":"+v"(negm));
  #define CMASK(P0,P1,t) do{}while(0)
  bool resc=false;
  #define START(P0,P1) do{ const float rm=FIXM?mfix:rowmax(P0,P1); resc=false; \
    { const float dl=rm; mhat=fadd_s(mhat,dl); \
      _Pragma("unroll") for(int r=0;r<16;++r){P0[r]=fsub_s(P0[r],dl);P1[r]=fsub_s(P1[r],dl);} \
      _Pragma("unroll") for(int r=0;r<16;++r)negm[r]=-mhat; asm volatile("":"+v"(negm)); } \
    _Pragma("unroll") for(int r=0;r<16;++r)P0[r]=__builtin_amdgcn_exp2f(P0[r]); }while(0)
  #define RESC() do{ if(resc){ asm volatile("s_waitcnt lgkmcnt(0)":::"memory"); \
      _Pragma("unroll") for(int d_=0;d_<2;++d_) _Pragma("unroll") for(int r=0;r<16;++r)o[d_][r]*=wsf[crow(r,hi)]; } }while(0)
  f32x16 pA0,pA1,pB0,pB1;
  int sl_prev=0,sl_cur=0,sl_next=SLOTB;
  #define ROT() do{sl_prev=sl_cur;sl_cur=sl_next;sl_next=(sl_next==(NSLOT-1)*SLOTB)?0:sl_next+SLOTB;}while(0)
  DMA_K(2,2*SLOTB);
  WAIT_BAR(3);
  qkt(pA0,pA1,Kbase,qr,negm,r32,hi);asm volatile("s_nop 15\n\ts_nop 7":"+v"(pA0),"+v"(pA1));CMASK(pA0,pA1,0);
  START(pA0,pA1);
  _Pragma("unroll") for(int r=0;r<16;++r)pA1[r]=__builtin_amdgcn_exp2f(pA1[r]);
  WAIT_BAR(0);
  DMA_K(3,0);DMA_V(1,SLOTB);
  ROT();
  kload8(kf,kp0+sl_cur);
  WAIT_BAR(2);
  s16x4 vlo[8],vhi[8]; u32x4 pw0,pw1,pw2,pw3;
  #define PKW(P,B) cvtpk_s(P[B],P[B+1])
  #define PAF(k) __builtin_bit_cast(bf16x8,pw##k)
  #define VFR(i) (bf16x8){vlo[i][0],vlo[i][1],vlo[i][2],vlo[i][3],vhi[i][0],vhi[i][1],vhi[i][2],vhi[i][3]}
  #define PIN(x) asm volatile("":"+v"(x))
  #define MX3(a,b,c) __builtin_fmaxf(__builtin_fmaxf((a),(b)),(c))
  #define GAPA(MF,A0,A1,A2,A3,W0,W1,PW) do{ MF; sacc+=A0; sacc+=A1; sacc+=A2; sacc+=A3; PIN(sacc); W0; W1; PIN(PW); SBAR(); }while(0)
  #define EX(v) __builtin_amdgcn_exp2f(v)
  #define GAPB(MF,X,B) do{ MF; X[B]=EX(X[B]); X[B+1]=EX(X[B+1]); X[B+2]=EX(X[B+2]); X[B+3]=EX(X[B+3]); PIN(X); SBAR(); }while(0)
  #define VRD(i) do{ vlo[i]=vtr(vp_+(((i)>>2)*4096+((i)&3)*1024)); vhi[i]=vtr(vp_+(((i)>>2)*4096+((i)&3)*1024+512)); }while(0)
  #define KRD(G,j) do{ if(G){ kload2(kf,kp0+sl_next,j); SBAR(); } }while(0)
  #define STEP(C0,C1,P0,P1,t,GK,GV,GL) do{ SBAR(); \
    const lds_cptr vp_=vp0+sl_prev; \
    VRD(0); SBAR(); float sacc=(P0[0]+P0[1]); \
    GAPA(C0=__builtin_amdgcn_mfma_f32_32x32x16_bf16(kf[0],qr[0],negm,0,0,0), P0[2],P0[3],P0[4],P0[5],     pw0[0]=PKW(P0,0), pw0[1]=PKW(P0,2), pw0); \
    VRD(4); SBAR(); GAPA(C1=__builtin_amdgcn_mfma_f32_32x32x16_bf16(kf[1],qr[0],negm,0,0,0), P0[6],P0[7],P0[8],P0[9],     pw0[2]=PKW(P0,4), pw0[3]=PKW(P0,6), pw0); \
    VRD(1); SBAR(); GAPA(C0=__builtin_amdgcn_mfma_f32_32x32x16_bf16(kf[2],qr[1],C0,0,0,0),   P0[10],P0[11],P0[12],P0[13], pw1[0]=PKW(P0,8), pw1[1]=PKW(P0,10), pw1); \
    VRD(5); SBAR(); GAPA(C1=__builtin_amdgcn_mfma_f32_32x32x16_bf16(kf[3],qr[1],C1,0,0,0),   P0[14],P0[15],P1[0],P1[1],   pw1[2]=PKW(P0,12),pw1[3]=PKW(P0,14), pw1); \
    VRD(2); SBAR(); GAPA(C0=__builtin_amdgcn_mfma_f32_32x32x16_bf16(kf[4],qr[2],C0,0,0,0),   P1[2],P1[3],P1[4],P1[5],     pw2[0]=PKW(P1,0), pw2[1]=PKW(P1,2), pw2); \
    VRD(6); SBAR(); GAPA(C1=__builtin_amdgcn_mfma_f32_32x32x16_bf16(kf[5],qr[2],C1,0,0,0),   P1[6],P1[7],P1[8],P1[9],     pw2[2]=PKW(P1,4), pw2[3]=PKW(P1,6), pw2); \
    VRD(3); SBAR(); GAPA(C0=__builtin_amdgcn_mfma_f32_32x32x16_bf16(kf[6],qr[3],C0,0,0,0),   P1[10],P1[11],P1[12],P1[13], pw3[0]=PKW(P1,8), pw3[1]=PKW(P1,10), pw3); \
    VRD(7); SBAR(); GAPA(C1=__builtin_amdgcn_mfma_f32_32x32x16_bf16(kf[7],qr[3],C1,0,0,0),   P1[14],P1[15],0.f,0.f,       pw3[2]=PKW(P1,12),pw3[3]=PKW(P1,14), pw3); \
    l_reg+=sacc; \
    if(GK){DMA_K((t)+3,sl_cur);} if(GV){DMA_V((t)+1,sl_next);} \
    CMASK(C0,C1,t); \
    if(!FIXM){ float a=MX3(C0[0],C0[1],C1[0]),b=MX3(C0[2],C0[3],C1[1]); a=MX3(a,C1[2],C1[3]); \
      _Pragma("unroll") for(int r=4;r<16;r+=4){a=MX3(a,C0[r],C0[r+1]);b=MX3(b,C0[r+2],C0[r+3]);a=MX3(a,C1[r],C1[r+1]);b=MX3(b,C1[r+2],C1[r+3]);} \
      float rm=__builtin_fmaxf(a,b); { auto rr=__builtin_amdgcn_permlane32_swap(__float_as_uint(rm),__float_as_uint(rm),false,false); rm=__builtin_fmaxf(__uint_as_float(rr[0]),__uint_as_float(rr[1])); } \
      resc=false; \
      if(__builtin_expect(__any(rm>(float)THRL),0)){ const float dl=__builtin_fmaxf(rm,0.f); mhat+=dl; \
        _Pragma("unroll") for(int r=0;r<16;++r){C0[r]-=dl;C1[r]-=dl;} \
        _Pragma("unroll") for(int r=0;r<16;++r)negm[r]=-mhat; asm volatile("":"+v"(negm)); \
        const float f=__builtin_amdgcn_exp2f(-dl); l_reg*=f; if(hi==0)wsf[r32]=f; resc=true; } } \
    SBAR(); \
    GAPB(o[0]=__builtin_amdgcn_mfma_f32_32x32x16_bf16(PAF(0),VFR(0),o[0],0,0,0), C0,0); \
    GAPB(o[1]=__builtin_amdgcn_mfma_f32_32x32x16_bf16(PAF(0),VFR(4),o[1],0,0,0), C0,4); \
    KRD(GL,0); GAPB(o[0]=__builtin_amdgcn_mfma_f32_32x32x16_bf16(PAF(1),VFR(1),o[0],0,0,0), C0,8); \
    KRD(GL,1); GAPB(o[1]=__builtin_amdgcn_mfma_f32_32x32x16_bf16(PAF(1),VFR(5),o[1],0,0,0), C0,12); \
    KRD(GL,2); GAPB(o[0]=__builtin_amdgcn_mfma_f32_32x32x16_bf16(PAF(2),VFR(2),o[0],0,0,0), C1,0); \
    KRD(GL,3); GAPB(o[1]=__builtin_amdgcn_mfma_f32_32x32x16_bf16(PAF(2),VFR(6),o[1],0,0,0), C1,4); \
    GAPB(o[0]=__builtin_amdgcn_mfma_f32_32x32x16_bf16(PAF(3),VFR(3),o[0],0,0,0), C1,8); \
    GAPB(o[1]=__builtin_amdgcn_mfma_f32_32x32x16_bf16(PAF(3),VFR(7),o[1],0,0,0), C1,12); \
    }while(0)
  int t=1;
  #undef CMASK
  #define CMASK(P0,P1,t) do{}while(0)
  for(;t+5<NT;t+=2){
    STEP(pB0,pB1,pA0,pA1,t,true,true,true);     WAIT_BAR(2); RESC(); ROT();
    STEP(pA0,pA1,pB0,pB1,t+1,true,true,true);   WAIT_BAR(2); RESC(); ROT();
  }
  #undef CMASK
  #define CMASK(P0,P1,t) do{}while(0)
  #define ENDW(tt) do{ if((tt)+3<NT){WAIT_BAR(2);} else if((tt)+2<NT){WAIT_BAR(1);} else {WAIT_BAR(0);} }while(0)
  for(;t+1<NT;t+=2){
    STEP(pB0,pB1,pA0,pA1,t,(t+3<NT),(t+1<NT),(t+1<NT));       ENDW(t);   RESC(); ROT();
    STEP(pA0,pA1,pB0,pB1,t+1,(t+4<NT),(t+2<NT),(t+2<NT));     ENDW(t+1); RESC(); ROT();
  }
  STEP(pB0,pB1,pA0,pA1,NT-1,false,false,false); RESC();
  { float sacc=pB0[0]+pB0[1]; _Pragma("unroll") for(int r=2;r<16;++r)sacc+=pB0[r]; _Pragma("unroll") for(int r=0;r<16;++r)sacc+=pB1[r]; l_reg+=sacc;
    pw0=(u32x4){PKW(pB0,0),PKW(pB0,2),PKW(pB0,4),PKW(pB0,6)};pw1=(u32x4){PKW(pB0,8),PKW(pB0,10),PKW(pB0,12),PKW(pB0,14)};pw2=(u32x4){PKW(pB1,0),PKW(pB1,2),PKW(pB1,4),PKW(pB1,6)};pw3=(u32x4){PKW(pB1,8),PKW(pB1,10),PKW(pB1,12),PKW(pB1,14)};
    SBAR(); pv(o,vb0+sl_cur,PAF(0),PAF(1),PAF(2),PAF(3)); }
  #undef PKW
  #undef PAF
  #undef VFR
  #undef PIN
  #undef MX3
  #undef GAPA
  #undef GAPB
  #undef EX
  #undef VRD
  #undef KRD
  #undef STEP
  #undef ENDW
  {auto rr=__builtin_amdgcn_permlane32_swap(__float_as_uint(l_reg),__float_as_uint(l_reg),false,false);l_reg=__uint_as_float(rr[0])+__uint_as_float(rr[1]);}
  if(hi==0)wsf[32+r32]=l_reg;asm volatile("s_waitcnt lgkmcnt(0)":::"memory");
  float rli[16];
  #pragma unroll
  for(int r=0;r<16;++r)rli[r]=__builtin_amdgcn_rcpf(wsf[32+crow(r,hi)]);
  bf16*Ow=O+(rowbase+q0+wid*QBLK)*OP+h*D;
  { bf16*stg=(bf16*)(shm+LDS_OST)+wid*2048;
    #pragma unroll
    for(int r=0;r<16;++r){const int orow=crow(r,hi);
      #pragma unroll
      for(int d0=0;d0<2;++d0)stg[orow*64+d0*32+r32]=__float2bfloat16(o[d0][r]*rli[r]);}
    asm volatile("s_waitcnt lgkmcnt(0)":::"memory");
    #pragma unroll
    for(int i=0;i<4;++i){const int row=i*8+(lane>>3),ch=lane&7; const u32x4 v=*(const u32x4*)(stg+row*64+ch*8); ATTN_STORE16(Ow+(long)row*OP+ch*8,v);} }
  asm volatile("s_waitcnt lgkmcnt(0)\n\ts_barrier":::"memory");
  #undef DMA_K
  #undef DMA_V
  #undef CMASK
  #undef START
  #undef RESC
  #undef ROT
}
constexpr int ATTN_LDS_BYTES=LDS_BYTES;
#undef SBAR
#undef WAIT_BAR
}
#define LAS __attribute__((address_space(3)))
#define XB_TMO      128
#define XB_XCNT(j)  (256  + 64 * (j))
#define XB_XSUB(j)  (1280 + 64 * (j))
#define XB_XGEN(j)  (2304 + 64 * (j))
#define XB_TOP      3328
#define XB_TOPGEN   3392
#define XCD_BAR_WORDS 3456
#define XB_SPIN_CAP (1u << 18)

__device__ __forceinline__ unsigned xb_ld(unsigned* p)              { return __hip_atomic_load(p, __ATOMIC_RELAXED, __HIP_MEMORY_SCOPE_AGENT); }
__device__ __forceinline__ unsigned xb_add(unsigned* p, unsigned v) { return __hip_atomic_fetch_add(p, v, __ATOMIC_RELAXED, __HIP_MEMORY_SCOPE_AGENT); }
__device__ __forceinline__ unsigned xb_xcc_id() { return (unsigned)__builtin_amdgcn_s_getreg((3 << 11) | 20) & 0xFu; }
#define XB_SPIN(cond, bar) do { unsigned _sp = 0; while (cond) { __builtin_amdgcn_s_sleep(1); \
    if ((++_sp & 255u) == 0u) { if (xb_ld(&(bar)[XB_TMO])) break; if (_sp > XB_SPIN_CAP) { atomicAdd(&(bar)[XB_TMO], 1u); break; } } } } while (0)

struct XcdBarrier {
    unsigned* bar; unsigned x;
    volatile LAS unsigned* st;
};

__device__ __forceinline__ XcdBarrier xcd_barrier_post(unsigned* bar, volatile LAS unsigned* st, int tid) {
    XcdBarrier b; b.bar = bar; b.x = xb_xcc_id(); b.st = st;
    if (tid == 0) (void)xb_add(&bar[XB_XCNT(b.x)], 1u);
    return b;
}
__device__ __forceinline__ void xcd_barrier_complete(unsigned* bar, unsigned x, unsigned& nloc, unsigned& nx) {
    const unsigned G = gridDim.x * gridDim.y * gridDim.z;
    unsigned sum, cnt, mine, sp = 0u;
    for (;;) {
        sum = 0u; cnt = 0u; mine = 0u;
#pragma unroll
        for (unsigned j = 0; j < 16; ++j) { const unsigned c = xb_ld(&bar[XB_XCNT(j)]); sum += c; cnt += (c > 0u) ? 1u : 0u; mine = (j == x) ? c : mine; }
        if (sum == G) break;
        __builtin_amdgcn_s_sleep(1);
        if ((++sp & 255u) == 0u) { if (xb_ld(&bar[XB_TMO])) break; if (sp > XB_SPIN_CAP) { atomicAdd(&bar[XB_TMO], 1u); break; } }
    }
    nloc = mine > 0u ? mine : 1u; nx = cnt > 0u ? cnt : 1u;
}

__device__ __forceinline__ void xcd_barrier(const XcdBarrier& b, int tid) {
    asm volatile("s_waitcnt vmcnt(0)" ::: "memory");
    __syncthreads();
    if (tid == 0) {
        unsigned* bar = b.bar;
        __builtin_amdgcn_s_waitcnt(0);
        unsigned nloc = b.st[0], nx = b.st[1];
        if (nloc == 0u) { xcd_barrier_complete(bar, b.x, nloc, nx); b.st[0] = nloc; b.st[1] = nx; }
        const unsigned old = xb_add(&bar[XB_XSUB(b.x)], 1u);
        const unsigned gen = old / nloc;
        if (old + 1u == (gen + 1u) * nloc) {
            __builtin_amdgcn_fence(__ATOMIC_RELEASE, "agent");
            asm volatile("s_waitcnt vmcnt(0)" ::: "memory");
            const unsigned og = xb_add(&bar[XB_TOP], 1u);
            const unsigned tg = og / nx;
            if (og + 1u == (tg + 1u) * nx) xb_add(&bar[XB_TOPGEN], 1u);
            else XB_SPIN(xb_ld(&bar[XB_TOPGEN]) == tg, bar);
            __builtin_amdgcn_fence(__ATOMIC_ACQUIRE, "agent");
            xb_add(&bar[XB_XGEN(b.x)], 1u);
            asm volatile("s_waitcnt vmcnt(0)" ::: "memory");
        } else {
            XB_SPIN(xb_ld(&bar[XB_XGEN(b.x)]) == gen, bar);
            __builtin_amdgcn_fence(__ATOMIC_ACQUIRE, "agent");
            asm volatile("s_waitcnt vmcnt(0)" ::: "memory");
        }
    }
    __syncthreads();
}
namespace mk {
typedef unsigned short bf16_t;
typedef float f32x4 __attribute__((ext_vector_type(4)));
typedef float f32x2 __attribute__((ext_vector_type(2)));
typedef unsigned u32x4 __attribute__((ext_vector_type(4)));
typedef unsigned u32x2 __attribute__((ext_vector_type(2)));
constexpr int TA = 16640, TL = 16384, M = 33280, NCH = 130;
constexpr float EPS = 1e-6f;
constexpr float C2 = 0.125f * 1.4426950408889634f;
constexpr size_t MiB = 1u << 20, KiB = 1u << 10;
constexpr size_t WS_WIN = 0, SZ_WIN = (size_t)5376 * 1024 * 2;
constexpr size_t WS_WBRA = 21 * MiB, SZ_WBRA = (size_t)1024 * 512 * 2;
constexpr size_t SZ_WBR3 = (size_t)1024 * 1024 * 2;
constexpr size_t WS_WBRR = 23 * MiB, SZ_WBRR = (size_t)1024 * 256 * 2;
constexpr size_t WS_WBRS = 24 * MiB;
constexpr size_t WS_WOUT = 25 * MiB, SZ_WOUT = (size_t)1024 * 1024 * 2;
constexpr size_t WS_WUP = 29 * MiB, SZ_WUP = (size_t)5632 * 1024 * 2;
constexpr size_t WS_WDN = 51 * MiB, SZ_WDN = (size_t)1024 * 2816 * 2;
constexpr size_t WS_WGLU = 62 * MiB, SZ_WGLU = (size_t)256 * 256 * 2;
constexpr size_t WS_MOD = 62 * MiB + 256 * KiB;
constexpr size_t WS_ROPE = WS_MOD + 160 * KiB;
constexpr size_t WS_LAMB = WS_ROPE + 32 * KiB;
constexpr size_t WS_LAML = WS_LAMB + 32 * KiB;
constexpr size_t WS_BBAR = WS_LAML + 32 * KiB;
constexpr size_t WS_CTL = 63 * MiB, CTL_BYTES = 16 * KiB;
constexpr size_t WS_XC = 64 * MiB;
constexpr size_t WS_H = 66 * MiB;
constexpr size_t WS_YA = WS_H, WS_YR = WS_H + (size_t)M * 512 * 2, WS_YS = WS_YR + (size_t)M * 256 * 2;
constexpr size_t WS_Z = 131 * MiB;
constexpr size_t WS_ZQ = WS_Z, WS_ZKV = WS_ZQ + (size_t)M * 512 * 2, WS_ZH = WS_ZKV + (size_t)M * 256 * 2, WS_ZU = WS_ZH + (size_t)M * 1280 * 2, WS_ZG = WS_ZU + (size_t)M * 256 * 2;
constexpr size_t WS_ZEND = WS_ZG + (size_t)M * 3072 * 2;
constexpr size_t WS_M16 = WS_Z;
constexpr size_t WS_HID = WS_Z;
constexpr size_t WS_PART = WS_Z + 200 * MiB;
constexpr size_t WS_HST = WS_ZEND;
constexpr size_t WS_DJ = WS_HST + (size_t)16 * 130 * 4096 * 4;
constexpr size_t WS_SST = WS_DJ + (size_t)16 * 130 * 64 * 4;
constexpr size_t WS_END = WS_SST + (size_t)64 * 130 * 64 * 8;
static_assert(WS_BBAR + 512 * KiB <= WS_XC && WS_M16 + (size_t)M * 2048 <= WS_ZH + (size_t)M * 512 && WS_HID + (size_t)M * 2816 * 2 <= WS_ZEND && WS_END <= 512 * MiB, "ws map");
constexpr int LDS_BYTES = 8 * 18432 + 1024, LDS_XB = 8 * 18432;

struct Args { const float* in[29]; float* out; unsigned char* ws; int ph_lo, ph_hi; };
typedef const __attribute__((address_space(4))) Args* ArgsP;
__device__ __forceinline__ ArgsP fresh_args() { ArgsP p = (ArgsP)__builtin_amdgcn_kernarg_segment_ptr(); asm volatile("" : "+s"(p)); return p; }

__device__ __forceinline__ float bf2f(unsigned short h) { return __uint_as_float(((unsigned)h) << 16); }
__device__ __forceinline__ unsigned f2bf(float f) { unsigned u = __builtin_bit_cast(unsigned, f); return (u + 0x7fffu + ((u >> 16) & 1u)) >> 16; }

__device__ __forceinline__ unsigned pk2hw(float lo, float hi) { typedef float f2v __attribute__((ext_vector_type(2))); typedef __bf16 b2v __attribute__((ext_vector_type(2))); f2v v = {lo, hi}; return __builtin_bit_cast(unsigned, __builtin_convertvector(v, b2v)); }
__device__ __forceinline__ unsigned pk2(float lo, float hi) { return pk2hw(lo, hi); }
__device__ __forceinline__ float sigm(float x) { return __builtin_amdgcn_rcpf(1.f + __expf(-x)); }
__device__ __forceinline__ float shx(float v, int lane, int m) { return __builtin_bit_cast(float, __builtin_amdgcn_ds_bpermute((lane ^ m) << 2, __builtin_bit_cast(int, v))); }
#define dppf(v, ctrl) __builtin_bit_cast(float, __builtin_amdgcn_update_dpp(0, __builtin_bit_cast(int, (float)(v)), (ctrl), 0xf, 0xf, true))
#define DPP_X1 0xB1
#define DPP_X2 0x4E
#define DPP_HM 0x141
#define DPP_RM 0x140
__device__ __forceinline__ float other32(float v, int hi) { auto rr = __builtin_amdgcn_permlane32_swap(__float_as_uint(v), __float_as_uint(v), false, false); return __uint_as_float(hi ? rr[0] : rr[1]); }
__device__ __forceinline__ float wave_sum(float v, int lane) {
    (void)lane;
    v += dppf(v, DPP_X1); v += dppf(v, DPP_X2); v += dppf(v, DPP_HM); v += dppf(v, DPP_RM);
    const int vi = __builtin_bit_cast(int, v);
    return (__builtin_bit_cast(float, __builtin_amdgcn_readlane(vi, 0)) + __builtin_bit_cast(float, __builtin_amdgcn_readlane(vi, 16)))
         + (__builtin_bit_cast(float, __builtin_amdgcn_readlane(vi, 32)) + __builtin_bit_cast(float, __builtin_amdgcn_readlane(vi, 48)));
}
__device__ __forceinline__ int rowof(int b, int dir, int n) { const int p = dir == 0 ? n : (n < 256 ? 255 - n : 16895 - n); return b * TA + p; }
#define LDS_WAIT() asm volatile("s_waitcnt lgkmcnt(0)" ::: "memory")
#define VM_WAIT() asm volatile("s_waitcnt vmcnt(0)" ::: "memory")

__device__ __forceinline__ void transpose_item(const float* W, int K, int N, bf16_t* WT, int mode, LAS float* scr, int item, int lane, int ldw = 0, int koff = 0) {
    if (ldw == 0) ldw = K;
    const int nblk = N / 32, kb = item / nblk, nb = item % nblk, k0 = 64 * kb, n0 = 32 * nb;
    int r0 = n0;
    if (mode == 1) { r0 = (n0 < 2816) ? (n0 / 128) * 256 + (n0 % 128) : ((n0 - 2816) / 128) * 256 + 128 + ((n0 - 2816) % 128); }
    float wv[32];
#pragma unroll
    for (int i = 0; i < 32; ++i) wv[i] = W[(size_t)(k0 + 2 * i + (lane >> 5)) * N + n0 + (lane & 31)];
#pragma unroll
    for (int i = 0; i < 32; ++i) scr[(2 * i + (lane >> 5)) * 33 + (lane & 31)] = wv[i];
    LDS_WAIT();
    const int c = lane & 7;
#pragma unroll
    for (int j = 0; j < 4; ++j) { const int n = (lane >> 3) + 8 * j; const LAS float* s = scr + (8 * c) * 33 + n;
        u32x4 o; o.x = pk2(s[0 * 33], s[1 * 33]); o.y = pk2(s[2 * 33], s[3 * 33]); o.z = pk2(s[4 * 33], s[5 * 33]); o.w = pk2(s[6 * 33], s[7 * 33]);
        *(u32x4*)(WT + (size_t)(r0 + n) * ldw + koff + k0 + 8 * c) = o; }
    LDS_WAIT();
}

__device__ __forceinline__ void phase_prep(ArgsP A, LAS unsigned char* lds, int tid, int lane, int wave, int G, int bx) {
    unsigned char* ws = A->ws;
    { const int gid = bx * 512 + tid;
      if (gid < 4096) { const int pos = gid >> 4, j = gid & 15; const float inv = powf(10000.f, -(float)(2 * j) / 32.f); const float ang = (float)pos * inv;
          float* rp = (float*)(ws + WS_ROPE); rp[gid * 2] = cosf(ang); rp[gid * 2 + 1] = sinf(ang); }
      else if (gid < 8192) { const int e = gid - 4096;
          const float lre = A->in[13][e], lim = A->in[14][e], dt = expf(A->in[15][e >> 6]);
          const float th = lim * dt, er = expm1f(lre * dt), c = cosf(th), s = sinf(th), sh = sinf(0.5f * th);
          const float m1r = er * c - 2.f * sh * sh, m1i = (er + 1.f) * s;
          float lbr = m1r + 1.f, lbi = m1i;
          const float den = lre * lre + lim * lim, qr = (m1r * lre + m1i * lim) / den, qi = (m1i * lre - m1r * lim) / den;
          float* bb = (float*)(ws + WS_BBAR) + (size_t)e * 32;
          for (int ch = 0; ch < 16; ++ch) { const float br = A->in[16][e * 16 + ch], bi = A->in[17][e * 16 + ch]; bb[2 * ch] = qr * br - qi * bi; bb[2 * ch + 1] = qr * bi + qi * br; }
          float* lb = (float*)(ws + WS_LAMB); lb[2 * e] = lbr; lb[2 * e + 1] = lbi;
          for (int i = 0; i < 7; ++i) { const float r2 = lbr * lbr - lbi * lbi, i2 = 2.f * lbr * lbi; lbr = r2; lbi = i2; }
          float* ll = (float*)(ws + WS_LAML); ll[2 * e] = lbr; ll[2 * e + 1] = lbi; } }
    for (int it = bx; it < 192; it += G) {
        LAS float* cond = (LAS float*)lds;
        for (int i = tid; i < 3072; i += 512) { const int v = i >> 10, k = i & 1023; const float c = v < 2 ? A->in[1][v * 1024 + k] : A->in[3][k]; cond[i] = c / (1.f + expf(-c)); }
        __syncthreads();
        const int l = it / 96, n = (it % 96) * 64 + lane;
        const float* W = A->in[4] + (size_t)l * 1024 * 6144 + n;
        float a0 = 0.f, a1 = 0.f, a2 = 0.f; const int k0 = wave * 128;
        for (int kb = k0; kb < k0 + 128; kb += 32) { float wv[32];
#pragma unroll
            for (int i = 0; i < 32; ++i) wv[i] = W[(size_t)(kb + i) * 6144];
#pragma unroll
            for (int i = 0; i < 32; ++i) { a0 += cond[kb + i] * wv[i]; a1 += cond[1024 + kb + i] * wv[i]; a2 += cond[2048 + kb + i] * wv[i]; } }
        LAS float* red = cond + 3072;
        red[(wave * 3 + 0) * 64 + lane] = a0; red[(wave * 3 + 1) * 64 + lane] = a1; red[(wave * 3 + 2) * 64 + lane] = a2;
        __syncthreads();
        if (wave < 3) { float s = 0.f;
#pragma unroll
            for (int w = 0; w < 8; ++w) s += red[(w * 3 + wave) * 64 + lane];
            s += A->in[5][l * 6144 + n]; ((float*)(ws + WS_MOD))[(l * 3 + wave) * 6144 + n] = s; }
        __syncthreads();
    }
    LAS float* scr = (LAS float*)(lds + wave * 16384);
    const int gw = bx * 8 + wave, NGW = G * 8;
    constexpr int I_IN = 16 * 168, I_BA = 8 * 32, I_BR = 4 * 32, I_OUT = 16 * 32, I_UP = 16 * 176, I_DN = 44 * 32, I_GLU = 4 * 8;
    constexpr int I_L = I_IN + I_BA + 2 * I_BR + I_OUT + I_UP + I_DN + I_GLU;
    for (int it = gw; it < 2 * I_L; it += NGW) {
        const int l = it / I_L; int r = it % I_L;
        if (r < I_IN) { transpose_item(A->in[8] + (size_t)l * 1024 * 5376, 1024, 5376, (bf16_t*)(ws + WS_WIN + l * SZ_WIN), 0, scr, r, lane); continue; } r -= I_IN;
        if (r < I_BA) { transpose_item(A->in[23] + (size_t)l * 512 * 1024, 512, 1024, (bf16_t*)(ws + WS_WBRA + l * SZ_WBR3), 0, scr, r, lane, 1024, 0); continue; } r -= I_BA;
        if (r < I_BR) { transpose_item(A->in[24] + (size_t)l * 256 * 1024, 256, 1024, (bf16_t*)(ws + WS_WBRA + l * SZ_WBR3), 0, scr, r, lane, 1024, 512); continue; } r -= I_BR;
        if (r < I_BR) { transpose_item(A->in[25] + (size_t)l * 256 * 1024, 256, 1024, (bf16_t*)(ws + WS_WBRA + l * SZ_WBR3), 0, scr, r, lane, 1024, 768); continue; } r -= I_BR;
        if (r < I_OUT) { transpose_item(A->in[26] + (size_t)l * 1024 * 1024, 1024, 1024, (bf16_t*)(ws + WS_WOUT + l * SZ_WOUT), 0, scr, r, lane); continue; } r -= I_OUT;
        if (r < I_UP) { transpose_item(A->in[27] + (size_t)l * 1024 * 5632, 1024, 5632, (bf16_t*)(ws + WS_WUP + l * SZ_WUP), 1, scr, r, lane); continue; } r -= I_UP;
        if (r < I_DN) { transpose_item(A->in[28] + (size_t)l * 2816 * 1024, 2816, 1024, (bf16_t*)(ws + WS_WDN + l * SZ_WDN), 0, scr, r, lane); continue; } r -= I_DN;
        transpose_item(A->in[21] + (size_t)l * 256 * 256, 256, 256, (bf16_t*)(ws + WS_WGLU + l * SZ_WGLU), 0, scr, r, lane);
    }
}

__device__ __forceinline__ void phase_norm(ArgsP A, int l, int which, bool from_inputs, int lane, int wave, int G, int bx) {
    unsigned char* ws = A->ws; const int gw = bx * 8 + wave, NGW = G * 8;
    const float* xc = (const float*)(ws + WS_XC);
    const float* gain = A->in[6 + which] + l * 1024;
    for (int r = gw; r < M; r += NGW) {
        const int b = r / TA, p = r - b * TA; const bool ctx = p < 256;
        if (which == 1 && l == 1 && ctx) continue;
        const float* xrow = ctx ? (from_inputs ? A->in[2] : xc) + (size_t)(b * 256 + p) * 1024 : (from_inputs ? A->in[0] : A->out) + ((size_t)b * TL + (p - 256)) * 1024;
        const float* md = (const float*)(ws + WS_MOD) + (l * 3 + (ctx ? 2 : b)) * 6144 + which * 3072;
        f32x4 v[4]; float s = 0.f;
#pragma unroll
        for (int j = 0; j < 4; ++j) v[j] = ((const f32x4*)xrow)[lane + 64 * j];
        if (which == 0 && l == 1 && ctx) {
#pragma unroll
            for (int sl = 0; sl < 3; ++sl) { const f32x4* pr = (const f32x4*)((const float*)(ws + WS_PART) + ((size_t)sl * 512 + (b * 256 + p)) * 1024);
#pragma unroll
                for (int j = 0; j < 4; ++j) v[j] += pr[lane + 64 * j]; } }
#pragma unroll
        for (int j = 0; j < 4; ++j) s += (v[j].x * v[j].x + v[j].y * v[j].y) + (v[j].z * v[j].z + v[j].w * v[j].w);
        const float rstd = __builtin_amdgcn_rsqf(wave_sum(s, lane) * (1.f / 1024.f) + EPS);
        bf16_t* orow = (bf16_t*)(ws + WS_H) + (size_t)r * 1024;
#pragma unroll
        for (int j = 0; j < 4; ++j) { const int c = 4 * (lane + 64 * j);
            const f32x4 g = *(const f32x4*)(gain + c), sh = *(const f32x4*)(md + c), sc = *(const f32x4*)(md + 1024 + c);
            const f32x4 y = (v[j] * rstd) * g * (sc + 1.f) + sh;
            u32x2 o; o.x = pk2(y.x, y.y); o.y = pk2(y.z, y.w); *(u32x2*)(orow + c) = o; }
    }
}

__device__ __forceinline__ float hgrn_lb(ArgsP A, int l, int dir, int h, int lane) {
    if (l == 0) return 0.f;
    const float a0 = A->in[11][(0 * 2 + dir) * 256 + h * 64 + lane], a1 = A->in[11][(1 * 2 + dir) * 256 + h * 64 + lane];
    return 1.f / (1.f + expf(a0 - a1));
}
__device__ __forceinline__ void qk_load(ArgsP A, int r, int lane, unsigned short (&raw)[10]) {
    const bf16_t* zq = (const bf16_t*)(A->ws + WS_ZQ) + (size_t)r * 512; const bf16_t* zk = (const bf16_t*)(A->ws + WS_ZKV) + (size_t)r * 256;
#pragma unroll
    for (int hh = 0; hh < 10; ++hh) raw[hh] = hh < 8 ? zq[hh * 64 + lane] : zk[(hh - 8) * 64 + lane];
}
__device__ __forceinline__ void qk_finish(ArgsP A, int l, int r, int lane, const unsigned short (&raw)[10], float gq, float gk) {
    unsigned char* ws = A->ws;
    const int b = r / TA, p = r - b * TA; const bool lat = p >= 256; const int t = p - 256;
    const int j = lane & 15, pos = (lane < 32) ? (t >> 6) : (t & 63);
    float cs = 1.f, sn = 0.f;
    if (lat) { const f32x2 c2 = ((const f32x2*)(ws + WS_ROPE))[pos * 16 + j]; cs = c2.x; sn = c2.y; }
    bf16_t* zq = (bf16_t*)(ws + WS_ZQ) + (size_t)r * 512; bf16_t* zk = (bf16_t*)(ws + WS_ZKV) + (size_t)r * 256;
#pragma unroll
    for (int hh = 0; hh < 10; ++hh) {
        bf16_t* ptr = hh < 8 ? zq + hh * 64 + lane : zk + (hh - 8) * 64 + lane;
        const float x = bf2f(raw[hh]);
        const float ss = wave_sum(x * x, lane);
        float y = x * __builtin_amdgcn_rsqf(ss * (1.f / 64.f) + EPS) * (hh < 8 ? gq : gk);
        const float pr = shx(y, lane, 16);
        if (lat) y = (lane & 16) ? y * cs + pr * sn : y * cs - pr * sn;
        if (hh < 8) y *= C2;
        *ptr = (bf16_t)f2bf(y);
    }
}
typedef short bf16x8h __attribute__((ext_vector_type(8)));
constexpr int HQS = 72, HTS = 20;
__device__ __forceinline__ bf16x8h frag2(u32x2 lo, u32x2 hi) { u32x4 w; w.x = lo.x; w.y = lo.y; w.z = hi.x; w.w = hi.y; return __builtin_bit_cast(bf16x8h, w); }
template <bool C> __device__ __forceinline__ void hg_load(unsigned short (&rf)[16], unsigned short (&rq)[16], unsigned short (&rv)[16], const bf16_t* Zh, int b, int dir, int h, int n0, int lane) {
    const bf16_t* z0 = Zh + (size_t)rowof(b, dir, n0) * 1280 + h * 64 + lane; const int st = dir == 0 ? 1280 : -1280;
#pragma unroll
    for (int t = 0; t < 16; ++t) { const bf16_t* zr = z0 + t * st;
        rf[t] = zr[256 + dir * 256]; rv[t] = zr[768]; if (C) rq[t] = zr[0]; }
}
template <bool C> __device__ __forceinline__ float hg_stage(const unsigned short (&rf)[16], const unsigned short (&rq)[16], const unsigned short (&rv)[16], LAS bf16_t* L, float lb, int lane) {
    LAS bf16_t* Qt = L; LAS bf16_t* Kh = L + 16 * HQS; LAS bf16_t* KhT = L + 32 * HQS; LAS bf16_t* VT = KhT + 64 * HTS;
    float ec = 1.f; const float omlb = 1.f - lb;
#pragma unroll
    for (int t = 0; t < 16; ++t) {
        const float sg = sigm(bf2f(rf[t])), f = lb + omlb * sg, kin = omlb * (1.f - sg);
        ec *= f;
        const float eic = fminf(__builtin_amdgcn_rcpf(ec), 1.329228e36f);
        float qt = 0.f; if (C) { const float q = bf2f(rq[t]); qt = q * sigm(q) * ec; }
        const unsigned kq = pk2hw(kin * eic, qt);
        const bf16_t kh = (bf16_t)(kq & 0xffffu);
        Kh[t * HQS + lane] = kh; KhT[lane * HTS + t] = kh; VT[lane * HTS + t] = rv[t];
        if (C) Qt[t * HQS + lane] = (bf16_t)(kq >> 16);
    }
    ((LAS float*)(L + 32 * HQS + 128 * HTS))[lane] = ec;
    return ec;
}
__device__ __forceinline__ void hg_state(f32x4 (&S)[4][4], const LAS bf16_t* L, int col, int quad) {
    const LAS bf16_t* KhT = L + 32 * HQS; const LAS bf16_t* VT = KhT + 64 * HTS; const LAS float* Ef = (const LAS float*)(L + 32 * HQS + 128 * HTS);
    const u32x2 z2 = {0u, 0u};
    bf16x8h vf[4];
#pragma unroll
    for (int eb = 0; eb < 4; ++eb) vf[eb] = frag2(*(const LAS u32x2*)(VT + (16 * eb + col) * HTS + 4 * quad), z2);
#pragma unroll
    for (int db = 0; db < 4; ++db) { const bf16x8h ka = frag2(*(const LAS u32x2*)(KhT + (16 * db + col) * HTS + 4 * quad), z2); const f32x4 ef = *(const LAS f32x4*)(Ef + 16 * db + 4 * quad);
#pragma unroll
        for (int eb = 0; eb < 4; ++eb) S[db][eb] = __builtin_amdgcn_mfma_f32_16x16x32_bf16(ka, vf[eb], S[db][eb], 0, 0, 0) * ef; }
}
constexpr int HAS_ = 40;
__device__ __forceinline__ void task_hgrnA(ArgsP A, int l, int task, LAS float* wl, int lane) {
    unsigned char* ws = A->ws;
    const int j = task % NCH, chain = task / NCH, h = chain & 3, dir = (chain >> 2) & 1, b = chain >> 3;
    const float lb = hgrn_lb(A, l, dir, h, lane), omlb = 1.f - lb;
    LAS bf16_t* KtT = (LAS bf16_t*)wl; LAS bf16_t* VT = KtT + 64 * HAS_; LAS float* Ef = (LAS float*)(KtT + 128 * HAS_);
    const bf16_t* Zh = (const bf16_t*)(ws + WS_ZH);
    const int col = lane & 15, quad = lane >> 4;
    f32x4 S[4][4];
#pragma unroll
    for (int db = 0; db < 4; ++db)
#pragma unroll
        for (int eb = 0; eb < 4; ++eb) S[db][eb] = (f32x4){0.f, 0.f, 0.f, 0.f};
    float Dp = 1.f;
    unsigned short rf[32], rv[32];
#define HGA_LOAD(n0_) do { const bf16_t* z0 = Zh + (size_t)rowof(b, dir, (n0_)) * 1280 + h * 64 + lane; const int st = dir == 0 ? 1280 : -1280; \
        _Pragma("unroll") for (int t = 0; t < 32; ++t) { const bf16_t* zr = z0 + t * st; rf[t] = zr[256 + dir * 256]; rv[t] = zr[768]; } } while (0)
    HGA_LOAD(128 * j);
    for (int sb = 0; sb < 4; ++sb) {
        float pr = 1.f;
#pragma unroll
        for (int t = 31; t >= 0; --t) { const float sg = sigm(bf2f(rf[t])), f = lb + omlb * sg, kin = omlb * (1.f - sg);
            KtT[lane * HAS_ + t] = (bf16_t)(pk2hw(kin * pr, 0.f) & 0xffffu); VT[lane * HAS_ + t] = rv[t];
            pr *= f; }
        const float ec = pr; Ef[lane] = ec; Dp *= ec;
        if (sb < 3) HGA_LOAD(128 * j + 32 * (sb + 1));
        LDS_WAIT();
        { bf16x8h vf[4];
#pragma unroll
          for (int eb = 0; eb < 4; ++eb) vf[eb] = *(const LAS bf16x8h*)(VT + (16 * eb + col) * HAS_ + 8 * quad);
#pragma unroll
          for (int db = 0; db < 4; ++db) { const bf16x8h ka = *(const LAS bf16x8h*)(KtT + (16 * db + col) * HAS_ + 8 * quad); const f32x4 ef = *(const LAS f32x4*)(Ef + 16 * db + 4 * quad);
#pragma unroll
              for (int eb = 0; eb < 4; ++eb) S[db][eb] = __builtin_amdgcn_mfma_f32_16x16x32_bf16(ka, vf[eb], S[db][eb] * ef, 0, 0, 0); } }
        LDS_WAIT();
    }
#undef HGA_LOAD
    float* hst = (float*)(ws + WS_HST) + (size_t)(chain * NCH + j) * 4096;
#pragma unroll
    for (int db = 0; db < 4; ++db)
#pragma unroll
        for (int eb = 0; eb < 4; ++eb) { float* p = hst + (16 * db + 4 * quad) * 64 + 16 * eb + col; p[0] = S[db][eb].x; p[64] = S[db][eb].y; p[128] = S[db][eb].z; p[192] = S[db][eb].w; }
    ((float*)(ws + WS_DJ))[(chain * NCH + j) * 64 + lane] = Dp;
}
__device__ __forceinline__ void task_hgrnC(ArgsP A, int l, int task, LAS float* wl, int lane) {
    unsigned char* ws = A->ws;
    const int pb = task % NCH, t2 = task / NCH, h = t2 & 3, b = t2 >> 2;
    if (l == 1 && pb < 2) return;
    LAS bf16_t* L = (LAS bf16_t*)wl; const LAS bf16_t* Qt = L; const LAS bf16_t* Kh = L + 16 * HQS;
    const bf16_t* Zh = (const bf16_t*)(ws + WS_ZH); bf16_t* Yr = (bf16_t*)(ws + WS_H) + 512;
    const int col = lane & 15, quad = lane >> 4;
    float ng[4];
#pragma unroll
    for (int eb = 0; eb < 4; ++eb) ng[eb] = A->in[12][l * 64 + 16 * eb + col];
    for (int dir = 0; dir < 2; ++dir) {
        const int j = dir == 0 ? pb : (pb < 2 ? 1 - pb : 131 - pb), chain = (b * 2 + dir) * 4 + h;
        const float lb = hgrn_lb(A, l, dir, h, lane);
        f32x4 S[4][4];
        { const float* hst = (const float*)(ws + WS_HST) + (size_t)(chain * NCH + j) * 4096;
#pragma unroll
          for (int db = 0; db < 4; ++db)
#pragma unroll
              for (int eb = 0; eb < 4; ++eb) { const float* p = hst + (16 * db + 4 * quad) * 64 + 16 * eb + col; S[db][eb] = (f32x4){p[0], p[64], p[128], p[192]}; } }
        unsigned short rf[16], rq[16], rv[16];
        hg_load<true>(rf, rq, rv, Zh, b, dir, h, 128 * j, lane);
        for (int sb = 0; sb < 8; ++sb) {
            const int n0 = 128 * j + 16 * sb;
            hg_stage<true>(rf, rq, rv, L, lb, lane);
            if (sb < 7) hg_load<true>(rf, rq, rv, Zh, b, dir, h, n0 + 16, lane);
            unsigned short pp[16], pg[16];
            if (dir == 1) {
#pragma unroll
                for (int i = 0; i < 4; ++i) { const size_t row = (size_t)(rowof(b, dir, n0) + (dir == 0 ? 4 * quad + i : -(4 * quad + i)));
#pragma unroll
                    for (int eb = 0; eb < 4; ++eb) { pp[4 * i + eb] = Yr[row * 1024 + h * 64 + 16 * eb + col]; pg[4 * i + eb] = Zh[row * 1280 + 1024 + h * 64 + 16 * eb + col]; } } }
            LDS_WAIT();
            f32x4 pt = {0.f, 0.f, 0.f, 0.f};
#pragma unroll
            for (int kk = 0; kk < 2; ++kk) pt = __builtin_amdgcn_mfma_f32_16x16x32_bf16(*(const LAS bf16x8h*)(Kh + col * HQS + 8 * quad + 32 * kk), *(const LAS bf16x8h*)(Qt + col * HQS + 8 * quad + 32 * kk), pt, 0, 0, 0);
            { const int s0 = 4 * quad; if (s0 + 0 > col) pt.x = 0.f; if (s0 + 1 > col) pt.y = 0.f; if (s0 + 2 > col) pt.z = 0.f; if (s0 + 3 > col) pt.w = 0.f; }
            const u32x2 z2 = {0u, 0u}; u32x2 pw; pw.x = pk2hw(pt.x, pt.y); pw.y = pk2hw(pt.z, pt.w);
            const bf16x8h pf = frag2(pw, z2);
            f32x4 o[4];
            { const LAS bf16_t* VT = L + 32 * HQS + 64 * HTS;
              const bf16x8h qa0 = frag2(*(const LAS u32x2*)(Qt + col * HQS + 4 * quad), *(const LAS u32x2*)(Qt + col * HQS + 16 + 4 * quad));
              const bf16x8h qa1 = frag2(*(const LAS u32x2*)(Qt + col * HQS + 32 + 4 * quad), *(const LAS u32x2*)(Qt + col * HQS + 48 + 4 * quad));
#pragma unroll
              for (int eb = 0; eb < 4; ++eb) {
                  u32x2 a, c; a.x = pk2hw(S[0][eb].x, S[0][eb].y); a.y = pk2hw(S[0][eb].z, S[0][eb].w); c.x = pk2hw(S[1][eb].x, S[1][eb].y); c.y = pk2hw(S[1][eb].z, S[1][eb].w);
                  f32x4 acc = __builtin_amdgcn_mfma_f32_16x16x32_bf16(qa0, frag2(a, c), (f32x4){0.f, 0.f, 0.f, 0.f}, 0, 0, 0);
                  a.x = pk2hw(S[2][eb].x, S[2][eb].y); a.y = pk2hw(S[2][eb].z, S[2][eb].w); c.x = pk2hw(S[3][eb].x, S[3][eb].y); c.y = pk2hw(S[3][eb].z, S[3][eb].w);
                  acc = __builtin_amdgcn_mfma_f32_16x16x32_bf16(qa1, frag2(a, c), acc, 0, 0, 0);
                  o[eb] = __builtin_amdgcn_mfma_f32_16x16x32_bf16(pf, frag2(*(const LAS u32x2*)(VT + (16 * eb + col) * HTS + 4 * quad), z2), acc, 0, 0, 0); } }
            hg_state(S, L, col, quad);
#pragma unroll
            for (int i = 0; i < 4; ++i) { const size_t row = (size_t)(rowof(b, dir, n0) + (dir == 0 ? 4 * quad + i : -(4 * quad + i))); bf16_t* yp = Yr + row * 1024 + h * 64 + col;
                if (dir == 0) {
#pragma unroll
                    for (int eb = 0; eb < 4; eb += 2) { const unsigned w = pk2hw(o[eb][i], o[eb + 1][i]); yp[16 * eb] = (bf16_t)(w & 0xffffu); yp[16 * eb + 16] = (bf16_t)(w >> 16); } }
                else { float tot[4], ss = 0.f;
#pragma unroll
                    for (int eb = 0; eb < 4; ++eb) { tot[eb] = o[eb][i] + bf2f(pp[4 * i + eb]); ss += tot[eb] * tot[eb]; }
                    ss += dppf(ss, DPP_X1); ss += dppf(ss, DPP_X2); ss += dppf(ss, DPP_HM); ss += dppf(ss, DPP_RM);
                    const float rs = __builtin_amdgcn_rsqf(ss * (1.f / 64.f) + EPS);
#pragma unroll
                    for (int eb = 0; eb < 4; eb += 2) { const float g0 = bf2f(pg[4 * i + eb]), g1 = bf2f(pg[4 * i + eb + 1]);
                        const unsigned w = pk2hw(tot[eb] * rs * ng[eb] * (g0 * sigm(g0)), tot[eb + 1] * rs * ng[eb + 1] * (g1 * sigm(g1))); yp[16 * eb] = (bf16_t)(w & 0xffffu); yp[16 * eb + 16] = (bf16_t)(w >> 16); } } }
            LDS_WAIT();
        }
        VM_WAIT();
    }
}
typedef short bf16x8v __attribute__((ext_vector_type(8)));
typedef float f32x16v __attribute__((ext_vector_type(16)));
__device__ __forceinline__ bf16x8v pack8v(const float* f) { u32x4 w; w.x = pk2(f[0], f[1]); w.y = pk2(f[2], f[3]); w.z = pk2(f[4], f[5]); w.w = pk2(f[6], f[7]); return __builtin_bit_cast(bf16x8v, w); }
__device__ __forceinline__ void s5_bfrag(const unsigned char* ws, int ebase, int jj, int hi, bf16x8v (&Bf)[4]) {
#pragma unroll
    for (int ch = 0; ch < 2; ++ch) { const float* bb = (const float*)(ws + WS_BBAR) + (size_t)(ebase + 32 * ch + jj) * 32 + 16 * hi; float re[8], im[8];
#pragma unroll
        for (int q = 0; q < 4; ++q) { const f32x4 v = *(const f32x4*)(bb + 4 * q); re[2 * q] = v.x; im[2 * q] = v.y; re[2 * q + 1] = v.z; im[2 * q + 1] = v.w; }
        Bf[2 * ch] = pack8v(re); Bf[2 * ch + 1] = pack8v(im); }
}
__device__ __forceinline__ void task_s5A(ArgsP A, int l, int task, LAS float* wl, int lane) {
    unsigned char* ws = A->ws;
    const int j = task % NCH, t2 = task / NCH, g = t2 & 15, dir = (t2 >> 4) & 1, b = t2 >> 5;
    const int jj = lane & 31, hi = lane >> 5, ebase = ((l * 2 + dir) * 16 + g) * 64;
    const f32x2 lamA = ((const f32x2*)(ws + WS_LAMB))[ebase + jj], lamB = ((const f32x2*)(ws + WS_LAMB))[ebase + 32 + jj];
    bf16x8v Bf[4]; s5_bfrag(ws, ebase, jj, hi, Bf);
    const bf16_t* Zu = (const bf16_t*)(ws + WS_ZU);
    float xr = 0.f, xi = 0.f;
    bf16x8v a1n = *(const bf16x8v*)(Zu + (size_t)rowof(b, dir, 128 * j + jj) * 256 + g * 16 + 8 * hi);
    bf16x8v a2n = *(const bf16x8v*)(Zu + (size_t)rowof(b, dir, 128 * j + (jj ^ 4)) * 256 + g * 16 + 8 * hi);
    for (int blk = 0; blk < 4; ++blk) {
        const bf16x8v a1 = a1n, a2 = a2n;
        if (blk < 3) { const int n1 = 128 * j + 32 * (blk + 1); a1n = *(const bf16x8v*)(Zu + (size_t)rowof(b, dir, n1 + jj) * 256 + g * 16 + 8 * hi); a2n = *(const bf16x8v*)(Zu + (size_t)rowof(b, dir, n1 + (jj ^ 4)) * 256 + g * 16 + 8 * hi); }
        const f32x16v z = {0.f, 0.f, 0.f, 0.f, 0.f, 0.f, 0.f, 0.f, 0.f, 0.f, 0.f, 0.f, 0.f, 0.f, 0.f, 0.f};
        const f32x16v c0 = __builtin_amdgcn_mfma_f32_32x32x16_bf16(a1, Bf[0], z, 0, 0, 0), c1 = __builtin_amdgcn_mfma_f32_32x32x16_bf16(a1, Bf[1], z, 0, 0, 0);
        const f32x16v c2 = __builtin_amdgcn_mfma_f32_32x32x16_bf16(a2, Bf[2], z, 0, 0, 0), c3 = __builtin_amdgcn_mfma_f32_32x32x16_bf16(a2, Bf[3], z, 0, 0, 0);
#pragma unroll
        for (int q = 0; q < 8; ++q) { const bool useA = ((q & 1) == hi); const float lr = useA ? lamA.x : lamB.x, li = useA ? lamA.y : lamB.y;
#pragma unroll
            for (int i = 0; i < 4; ++i) { const int r = 4 * (q >> 1) + i; const float bur = useA ? c0[r] : c2[r], bui = useA ? c1[r] : c3[r];
                const float nr = lr * xr - li * xi + bur, ni = lr * xi + li * xr + bui; xr = nr; xi = ni; }
            xr = other32(xr, hi); xi = other32(xi, hi); }
    }
    ((f32x2*)(ws + WS_SST))[((size_t)((b * 2 + dir) * 16 + g) * NCH + j) * 64 + lane] = (f32x2){xr, xi};
}
__device__ __forceinline__ void phase_m1(ArgsP A, int l, LAS unsigned char* lds, int lane, int wave, int G, int bx) {
    LAS float* wl = (LAS float*)(lds + wave * 18432);
    const int gw = bx * 8 + wave, NGW = G * 8;
    constexpr int NH = 16 * NCH, NS = 64 * NCH;
    const bool g256 = (G == 256);
    const int nH = g256 ? (gw < 32 ? 2 : 1) : 0, nS = g256 ? (gw < 32 ? 1 : (gw < 256 ? 5 : 4)) : 0;
    const int nIt = g256 ? nH + nS : (NH + NS - gw + NGW - 1) / NGW;
    for (int ii = 0; ii < nIt; ++ii) { const int i = (wave & 4) ? nIt - 1 - ii : ii; int th = -1, ts = -1;
        if (g256) { if (i < nH) th = gw + 2048 * i; else { const int k = i - nH; ts = gw < 32 ? 8064 + gw : (k < 4 ? (gw - 32) + 2016 * k : 8096 + (gw - 32)); } }
        else { const int t = gw + i * NGW; if (t < NH) th = t; else ts = t - NH; }
        if (th >= 0) task_hgrnA(A, l, th, wl, lane);
        else task_s5A(A, l, ts, wl, lane);
    }
}
__device__ __forceinline__ void phase_m2(ArgsP A, int l, int tid, int G, int bx) {
    unsigned char* ws = A->ws;
    for (int gid = bx * 512 + tid; gid < 65536 + 4096; gid += G * 512) {
        if (gid < 65536) { const int chain = gid >> 12, de = gid & 4095, d = de >> 6;
            float* base = (float*)(ws + WS_HST) + (size_t)chain * NCH * 4096 + de; const float* dj = (const float*)(ws + WS_DJ) + chain * NCH * 64 + d;
            float s = 0.f;
            for (int j0 = 0; j0 < NCH; j0 += 26) { float u[26], dd[26];
#pragma unroll
                for (int i = 0; i < 26; ++i) { u[i] = base[(size_t)(j0 + i) * 4096]; dd[i] = dj[(j0 + i) * 64]; }
#pragma unroll
                for (int i = 0; i < 26; ++i) { base[(size_t)(j0 + i) * 4096] = s; s = dd[i] * s + u[i]; } } }
        else { const int c = gid - 65536, cw = c >> 6, p = c & 63, g = cw & 15, dir = (cw >> 4) & 1;
            const f32x2 lL = ((const f32x2*)(ws + WS_LAML))[((l * 2 + dir) * 16 + g) * 64 + p];
            f32x2* base = (f32x2*)(ws + WS_SST) + (size_t)cw * NCH * 64 + p;
            float er = 0.f, ei = 0.f;
            for (int j0 = 0; j0 < NCH; j0 += 26) { f32x2 u[26];
#pragma unroll
                for (int i = 0; i < 26; ++i) u[i] = base[(j0 + i) * 64];
#pragma unroll
                for (int i = 0; i < 26; ++i) { base[(j0 + i) * 64] = (f32x2){er, ei}; const float nr = lL.x * er - lL.y * ei + u[i].x, ni = lL.x * ei + lL.y * er + u[i].y; er = nr; ei = ni; } } }
    }
}
__device__ __forceinline__ void task_s5C(ArgsP A, int l, int task, LAS float* wl, int lane) {
    unsigned char* ws = A->ws;
    const int pb = task % NCH, t2 = task / NCH, g = t2 & 15, b = t2 >> 4;
    if (l == 1 && pb < 2) return;
    LAS bf16_t* X = (LAS bf16_t*)wl;
    const int jj = lane & 31, hi = lane >> 5;
    const float dsk = A->in[20][l * 256 + g * 16 + (jj & 15)];
    const bf16_t* Zu = (const bf16_t*)(ws + WS_ZU); bf16_t* Ys = (bf16_t*)(ws + WS_H) + 768;
    for (int dir = 0; dir < 2; ++dir) {
        const int j = dir == 0 ? pb : (pb < 2 ? 1 - pb : 131 - pb);
        const int ebase = ((l * 2 + dir) * 16 + g) * 64;
        const f32x2 lamA = ((const f32x2*)(ws + WS_LAMB))[ebase + jj], lamB = ((const f32x2*)(ws + WS_LAMB))[ebase + 32 + jj];
        bf16x8v Bf[4]; s5_bfrag(ws, ebase, jj, hi, Bf);
        bf16x8v Cf[8];
#pragma unroll
        for (int kk = 0; kk < 8; ++kk) { float v[8]; const int p0 = 8 * kk + 4 * hi;
            const size_t co = ((size_t)(((l * 2 + dir) * 16 + g) * 16 + (jj & 15))) * 64 + p0;
            const f32x4 cr = *(const f32x4*)(A->in[18] + co), ci = *(const f32x4*)(A->in[19] + co); const float sgn = (jj < 16) ? 1.f : 0.f;
            v[0] = sgn * cr.x; v[1] = -sgn * ci.x; v[2] = sgn * cr.y; v[3] = -sgn * ci.y; v[4] = sgn * cr.z; v[5] = -sgn * ci.z; v[6] = sgn * cr.w; v[7] = -sgn * ci.w;
            Cf[kk] = pack8v(v); }
        const f32x2 x0 = ((const f32x2*)(ws + WS_SST))[((size_t)((b * 2 + dir) * 16 + g) * NCH + j) * 64 + lane];
        float xr = x0.x, xi = x0.y;
        bf16x8v a1n = *(const bf16x8v*)(Zu + (size_t)rowof(b, dir, 128 * j + jj) * 256 + g * 16 + 8 * hi);
        bf16x8v a2n = *(const bf16x8v*)(Zu + (size_t)rowof(b, dir, 128 * j + (jj ^ 4)) * 256 + g * 16 + 8 * hi);
        for (int blk = 0; blk < 4; ++blk) {
            const int n0 = 128 * j + 32 * blk;
            const bf16x8v a1 = a1n, a2 = a2n;
            if (blk < 3) { a1n = *(const bf16x8v*)(Zu + (size_t)rowof(b, dir, n0 + 32 + jj) * 256 + g * 16 + 8 * hi); a2n = *(const bf16x8v*)(Zu + (size_t)rowof(b, dir, n0 + 32 + (jj ^ 4)) * 256 + g * 16 + 8 * hi); }
            unsigned short pre[16];
            if (jj < 16) {
#pragma unroll
                for (int r = 0; r < 16; ++r) { const int t = (r & 3) + 8 * (r >> 2) + 4 * hi; const size_t rw = (size_t)(rowof(b, dir, n0) + (dir == 0 ? t : -t));     pre[r] = dir == 0 ? Zu[rw * 256 + g * 16 + jj] : Ys[rw * 1024 + g * 16 + jj]; } }
            const f32x16v z = {0.f, 0.f, 0.f, 0.f, 0.f, 0.f, 0.f, 0.f, 0.f, 0.f, 0.f, 0.f, 0.f, 0.f, 0.f, 0.f};
            const f32x16v c0 = __builtin_amdgcn_mfma_f32_32x32x16_bf16(a1, Bf[0], z, 0, 0, 0), c1 = __builtin_amdgcn_mfma_f32_32x32x16_bf16(a1, Bf[1], z, 0, 0, 0);
            const f32x16v c2 = __builtin_amdgcn_mfma_f32_32x32x16_bf16(a2, Bf[2], z, 0, 0, 0), c3 = __builtin_amdgcn_mfma_f32_32x32x16_bf16(a2, Bf[3], z, 0, 0, 0);
#pragma unroll
            for (int q = 0; q < 8; ++q) { const bool useA = ((q & 1) == hi); const float lr = useA ? lamA.x : lamB.x, li = useA ? lamA.y : lamB.y; const int pc = useA ? jj : 32 + jj;
#pragma unroll
                for (int i = 0; i < 4; ++i) { const int r = 4 * (q >> 1) + i; const float bur = useA ? c0[r] : c2[r], bui = useA ? c1[r] : c3[r];
                    const float nr = lr * xr - li * xi + bur, ni = lr * xi + li * xr + bui; xr = nr; xi = ni;
                    const int t = 4 * q + i; *(LAS unsigned*)(X + t * 136 + 2 * pc) = pk2hw(xr, xi); }
                xr = other32(xr, hi); xi = other32(xi, hi); }
            LDS_WAIT();
            f32x16v y = z;
#pragma unroll
            for (int kk = 0; kk < 8; ++kk) { const bf16x8v xf = *(const LAS bf16x8v*)(X + jj * 136 + 16 * kk + 8 * hi); y = __builtin_amdgcn_mfma_f32_32x32x16_bf16(xf, Cf[kk], y, 0, 0, 0); }
            if (jj < 16) {
#pragma unroll
                for (int r = 0; r < 16; ++r) { const int t = (r & 3) + 8 * (r >> 2) + 4 * hi; const int row = rowof(b, dir, n0) + (dir == 0 ? t : -t);
                    bf16_t* yp = Ys + (size_t)row * 1024 + g * 16 + jj;
                    if (dir == 0) *yp = (bf16_t)f2bf(dsk * bf2f(pre[r]) + y[r]);
                    else { const float v = bf2f(pre[r]) + y[r]; const float tt = 1.5957691216f * (v + 0.044715f * v * v * v); *yp = (bf16_t)f2bf(v * __builtin_amdgcn_rcpf(1.f + __expf(-tt))); } } }
            LDS_WAIT();
        }
        VM_WAIT();
    }
}
}

using namespace mk;
#define PHASE_BEGIN { ArgsP A = fresh_args(); if (ph >= A->ph_lo && ph < A->ph_hi) { unsigned char* ws = A->ws; (void)ws; int lane = lane_id_fresh(); int wave = wave0; asm volatile("" : "+s"(wave)); const int tid = wave * 64 + lane; (void)tid; int G = gridDim.x, bx = blockIdx.x; asm volatile("" : "+s"(G), "+s"(bx)); (void)G; (void)bx;
#define PHASE_END   if (ph + 1 < A->ph_hi) xcd_barrier(xbar, wave0 * 64 + lane_id_fresh()); } } ++ph;
template <int l> __device__ __forceinline__ void layer_body(const XcdBarrier& xbar, int& ph, LAS unsigned char* lds, unsigned char* lds_raw, const int wave0) {
        constexpr int lo = (l == 1) ? 1 : 0, nMt = lo ? 128 : 130;
        PHASE_BEGIN phase_norm(A, l, 0, l == 0, lane, wave, G, bx); PHASE_END
        PHASE_BEGIN { pg8::Gemm g{(const bf16_t*)(ws + WS_H), (const bf16_t*)(ws + WS_WIN + l * SZ_WIN), M, 5376, 1024}; pg8::MapOrder S; S.init(130, 5376, G, bx, 0);
            pg8::EpiRoute E{(bf16_t*)(ws + WS_ZQ), (bf16_t*)(ws + WS_ZKV), (bf16_t*)(ws + WS_ZH), (bf16_t*)(ws + WS_ZU), (bf16_t*)(ws + WS_ZG)};
            pg8::gemm_phase<pg8::EpiRoute, pg8::MapOrder, true, true>(lds, g, S, E, wave0); __syncthreads(); } PHASE_END
        PHASE_BEGIN phase_m1(A, l, lds, lane, wave, G, bx); PHASE_END
        PHASE_BEGIN { phase_m2(A, l, tid, G, bx);
            const int nsb = (65536 + 4096 + 511) / 512, fb = (G > nsb + 8) ? nsb : 0, NGW = G * 8, gw = bx * 8 + wave;
            const int R1 = fb > 0 ? M - 7 * NGW : 0;
            const int r0 = (bx - fb) * 8 + wave, rs = (G - fb) * 8;
            const int n1 = (bx >= fb && r0 < R1) ? (R1 - r0 + rs - 1) / rs : 0, n2 = (R1 + gw < M) ? (M - R1 - gw + NGW - 1) / NGW : 0;
            { const float gq = A->in[9][l * 64 + lane], gk = A->in[10][l * 64 + lane];
              unsigned short cur[10], nxt[10];
#define QKROW(i_) ((i_) < n1 ? r0 + (i_) * rs : R1 + gw + ((i_) - n1) * NGW)
              if (n1 + n2 > 0) qk_load(A, QKROW(0), lane, cur);
              for (int i = 0; i < n1 + n2; ++i) { if (i + 1 < n1 + n2) qk_load(A, QKROW(i + 1), lane, nxt); qk_finish(A, l, QKROW(i), lane, cur, gq, gk);
#pragma unroll
                  for (int hh = 0; hh < 10; ++hh) cur[hh] = nxt[hh]; }
#undef QKROW
            } } PHASE_END
        PHASE_BEGIN {
            LAS float* wl = (LAS float*)(lds + wave * 18432);
            const int gw = bx * 8 + wave, NGW = G * 8;
            constexpr int NHC = 8 * NCH, NSC = 32 * NCH;
            (void)gw; (void)NGW;
            { const int th = bx + G * wave; if (th < NHC) task_hgrnC(A, l, th, wl, lane); }
            { int t0 = bx + G * ((wave + 4) & 7), st = 8 * G, n0 = (NSC - t0 + st - 1) / st, tx = -1;
              if (G == 256) { st = 1024;
                  if (wave < 4) { t0 = 3072 + bx + 256 * wave; n0 = 1; }
                  else { t0 = bx + 256 * (wave - 4); n0 = 3;
                      if (bx < 16) { if (wave == 4) n0 = 0; else tx = bx + 1024 * (wave - 5); }
                      else if (wave == 4 && bx >= 64 && bx < 128) tx = 4096 + bx - 64; } }
              const int nt_ = n0 + (tx >= 0 ? 1 : 0);
              for (int it = 0; it < nt_; ++it) { const int t = it < n0 ? t0 + st * it : tx; task_s5C(A, l, t, wl, lane); } }
            __syncthreads();
            const int NU = (l == 0) ? 1040 : 1024;
            float mfix;
            { float mq = fabsf(A->in[9][l * 64 + lane]), mk_ = fabsf(A->in[10][l * 64 + lane]);
#pragma unroll
              for (int o = 1; o < 64; o <<= 1) { mq = fmaxf(mq, shx(mq, lane, o)); mk_ = fmaxf(mk_, shx(mk_, lane, o)); }
              mfix = 8.f * 1.4426950408889634f * mq * mk_ * 1.02f; }
            for (int u = bx; u < NU; u += G) {
                long rowbase; int q0, NT, h;
                if (u < 1024) { const int qb = u & 63, bh = u >> 6; h = bh & 7; rowbase = (long)(bh >> 3) * TA; q0 = 256 + 256 * qb; NT = 260; }
                else { const int c = u - 1024; h = c & 7; rowbase = (long)(c >> 3) * TA; q0 = 0; NT = 4; }
                attn_body::attn_unit<8, true>(mfix, rowbase, q0, NT, h, h >> 2, (const attn_body::bf16*)(ws + WS_ZQ), (const attn_body::bf16*)(ws + WS_ZKV), (const attn_body::bf16*)(ws + WS_ZKV) + 128, (attn_body::bf16*)(ws + WS_H), (char*)lds_raw, wave0);
            }
            __syncthreads();
        } PHASE_END
        PHASE_BEGIN { pg8::Gemm g{(const bf16_t*)(ws + WS_H) + 768, (const bf16_t*)(ws + WS_WGLU + l * SZ_WGLU), M, 256, 256, 1024}; pg8::MapOrder S; S.init(nMt, 256, G, bx, lo);
            pg8::EpiGlu E{(bf16_t*)(ws + WS_H) + 768, A->in[22] + l * 256, 1024};
            pg8::gemm_phase<pg8::EpiGlu, pg8::MapOrder, true, true>(lds, g, S, E, wave0); __syncthreads(); } PHASE_END
        PHASE_BEGIN { pg8::Gemm g{(const bf16_t*)(ws + WS_H), (const bf16_t*)(ws + WS_WBRA + l * SZ_WBR3), M, 1024, 1024, 0}; pg8::MapOrder S; S.init(nMt, 1024, G, bx, lo);
            pg8::EpiMerge3 E{(bf16_t*)(ws + WS_M16), (const bf16_t*)(ws + WS_ZG)};
            pg8::gemm_phase<pg8::EpiMerge3, pg8::MapOrder, true, true>(lds, g, S, E, wave0); __syncthreads(); } PHASE_END
        PHASE_BEGIN { pg8::Gemm g{(const bf16_t*)(ws + WS_M16), (const bf16_t*)(ws + WS_WOUT + l * SZ_WOUT), M, 1024, 1024}; pg8::MapOrder S; S.init(nMt, 1024, G, bx, lo);
            pg8::EpiResid E{l == 0 ? A->in[0] : A->out, l == 0 ? A->in[2] : (const float*)(ws + WS_XC), A->out, (float*)(ws + WS_XC), (const float*)(ws + WS_MOD) + l * 3 * 6144 + 2 * 1024};
            pg8::gemm_phase<pg8::EpiResid, pg8::MapOrder, true, true>(lds, g, S, E, wave0); __syncthreads(); } PHASE_END
        PHASE_BEGIN phase_norm(A, l, 1, false, lane, wave, G, bx); PHASE_END
        PHASE_BEGIN { pg8::Gemm g{(const bf16_t*)(ws + WS_H), (const bf16_t*)(ws + WS_WUP + l * SZ_WUP), M, 5632, 1024}; pg8::MapOrder S; S.init(nMt, 5632, G, bx, lo);
            pg8::EpiSwiglu E{(bf16_t*)(ws + WS_HID)};
            pg8::gemm_phase<pg8::EpiSwiglu, pg8::MapOrder, true, true>(lds, g, S, E, wave0); __syncthreads(); } PHASE_END
        PHASE_BEGIN { const float* g2 = (const float*)(ws + WS_MOD) + l * 3 * 6144 + 5 * 1024;
            { pg8::Gemm g{(const bf16_t*)(ws + WS_HID), (const bf16_t*)(ws + WS_WDN + l * SZ_WDN), M, 1024, 2816, 0, 0}; pg8::MapOrder S; S.init(128, 1024, G, bx, 1);
              pg8::EpiResid E{A->out, (const float*)(ws + WS_XC), A->out, (float*)(ws + WS_XC), g2};
              pg8::gemm_phase<pg8::EpiResid, pg8::MapOrder, true, true>(lds, g, S, E, wave0); __syncthreads(); }
            if (l == 0) {
                { pg8::Gemm g{(const bf16_t*)(ws + WS_HID), (const bf16_t*)(ws + WS_WDN), M, 1024, 768, 2816, 2816}; pg8::MapOrder S; S.init(2, 1024, G, bx, 2);
                  pg8::EpiResid E{A->out, (const float*)(ws + WS_XC), A->out, (float*)(ws + WS_XC), g2};
                  pg8::gemm_phase<pg8::EpiResid, pg8::MapOrder, true, true>(lds, g, S, E, wave0); __syncthreads(); }
#pragma nounroll
                for (int s = 1; s < 4; ++s) { const int koff = s == 1 ? 768 : s == 2 ? 1536 : 2176, ks = s == 1 ? 768 : 640;
                    pg8::Gemm g{(const bf16_t*)(ws + WS_HID) + koff, (const bf16_t*)(ws + WS_WDN) + koff, M, 1024, ks, 2816, 2816}; pg8::MapOrder S; S.init(2, 1024, G, (bx + G - 8 * s) % G, 2);
                    pg8::EpiPart E{(float*)(ws + WS_PART) + (size_t)(s - 1) * 512 * 1024, g2 + 2 * 6144};
                    pg8::gemm_phase<pg8::EpiPart, pg8::MapOrder, true, true>(lds, g, S, E, wave0); __syncthreads(); } } } PHASE_END
    }

__global__ void __launch_bounds__(512, 2) mk_fwd(mk::Args Aval) {
    using namespace mk;
    extern __shared__ __attribute__((aligned(16))) unsigned char lds_raw[];
    LAS unsigned char* lds = (LAS unsigned char*)lds_raw;
    cooperative_groups::grid_group grid = cooperative_groups::this_grid();
    int ph = 0;
    const int wave0 = __builtin_amdgcn_readfirstlane(threadIdx.x >> 6);
    XcdBarrier xbar;
    { mk::ArgsP A0 = mk::fresh_args(); const int tid0 = threadIdx.x;
      if (tid0 < 8) ((LAS unsigned*)(lds + LDS_XB))[tid0] = 0u;
      __syncthreads();
      xbar = xcd_barrier_post((unsigned*)(A0->ws + WS_CTL), (volatile LAS unsigned*)(lds + LDS_XB), tid0);
      if (A0->ph_lo < 0) grid.sync(); }

    PHASE_BEGIN phase_prep(A, lds, tid, lane, wave, G, bx); PHASE_END

    layer_body<0>(xbar, ph, lds, lds_raw, wave0);
    layer_body<1>(xbar, ph, lds, lds_raw, wave0);
}

#ifndef MK_COOP
#define MK_COOP 1
#endif
extern "C" void kernel_launch(void* const* d_in, const int* in_sizes, int n_in, void* d_out, int out_size, void* d_ws, size_t ws_size, hipStream_t stream) {
    static int grid = 0;
    if (grid == 0) {
        if (n_in != 29 || ws_size < mk::WS_END) { fprintf(stderr, "kernel_launch: bad inputs (n_in %d, ws %zu < %zu)\n", n_in, ws_size, (size_t)mk::WS_END); grid = -1; return; }
        int dev = 0, cus = 0, per_cu = 0;
        hipGetDevice(&dev); hipDeviceGetAttribute(&cus, hipDeviceAttributeMultiprocessorCount, dev);
        hipFuncSetAttribute((const void*)mk_fwd, hipFuncAttributeMaxDynamicSharedMemorySize, mk::LDS_BYTES);
        hipOccupancyMaxActiveBlocksPerMultiprocessor(&per_cu, (const void*)mk_fwd, 512, mk::LDS_BYTES);
        (void)hipGetLastError();
        grid = cus > 0 ? cus : 256;
        fprintf(stderr, "kernel_launch: cus %d per_cu %d grid %d\n", cus, per_cu, grid);
    }
    if (grid < 0) return;
    if (hipMemsetAsync((char*)d_ws + mk::WS_CTL, 0, mk::CTL_BYTES, stream) != hipSuccess) { fprintf(stderr, "memset failed\n"); return; }
    mk::Args a{};
    for (int i = 0; i < 29; ++i) a.in[i] = (const float*)d_in[i];
    a.out = (float*)d_out; a.ws = (unsigned char*)d_ws;
#if MK_COOP
    a.ph_lo = 0; a.ph_hi = 23;
    void* args[] = {&a};
    hipError_t e = hipLaunchCooperativeKernel((const void*)mk_fwd, dim3(grid), dim3(512), args, mk::LDS_BYTES, stream);
    if (e != hipSuccess) fprintf(stderr, "cooperative launch failed: %s\n", hipGetErrorString(e));
#else
    for (int p = 0; p < 23; ++p) { a.ph_lo = p; a.ph_hi = p + 1; hipLaunchKernelGGL(mk_fwd, dim3(grid), dim3(512), mk::LDS_BYTES, stream, a); }
#endif
}
```

```cpp
#include <hip/hip_runtime.h>
#include <hip/hip_cooperative_groups.h>
#include <cstdio>
#include <cstdint>
__device__ __forceinline__ int lane_id_fresh() { int l; asm volatile("v_mbcnt_lo_u32_b32 %0, -1, 0\n\tv_mbcnt_hi_u32_b32 %0, -1, %0" : "=v"(l)); return l; }
namespace pg8 {
#define PG8_LAS __attribute__((address_space(3)))
typedef unsigned short bf16_t;
typedef short bf16x8 __attribute__((ext_vector_type(8)));
typedef float f32x4 __attribute__((ext_vector_type(4)));
typedef unsigned u32x4 __attribute__((ext_vector_type(4)));
constexpr int BM = 256, BK = 64, HALF = 128, HTB = HALF * BK * 2  , STAGE_BYTES = 8 * HTB, NXCD = 8, WGM = 8;

__host__ __device__ __forceinline__ int lds_byte(int r, int c) { const int st = (r >> 4) * 2 + (c >> 5), rr = r & 15, cc = c & 31, ob = rr * 64 + cc * 2; return st * 1024 + (ob ^ (((ob >> 9) & 1) << 5)); }
__host__ __device__ __forceinline__ void stage_rc(int b, int& R, int& C) { const int st = b / 1024, sb = b % 1024, swz = sb ^ (((sb >> 9) & 1) << 5); R = (st >> 1) * 16 + swz / 64; C = (st & 1) * 32 + (swz % 64) / 2; }
__host__ __device__ __forceinline__ int perm32(int rho) { const int n = rho >> 4, i = rho & 15; return 8 * (i >> 2) + 4 * n + (i & 3); }

struct Unit { int pm, pn; };
struct Gemm { const bf16_t* A; const bf16_t* Bt; int M, N, K; int lda, ldb; };

struct StaticOrder {
    int nM, nN, nwg, G, c;
    __host__ __device__ void init(int M, int N, int G_, int c_) { nM = M / BM; nN = N / BM; nwg = nM * nN; G = G_; c = c_; }
    __host__ __device__ bool next(int i, Unit& u) const {
        const long L = (long)i * G + c; if (L >= nwg) return false;
        int wgid = (int)L; { const int q = nwg / NXCD, r = nwg % NXCD, xcd = wgid % NXCD, off = wgid / NXCD; wgid = (xcd < r ? xcd * (q + 1) : r * (q + 1) + (xcd - r) * q) + off; }
        const int nig = WGM * nN, gid = wgid / nig, fm = gid * WGM, gsz = (nM - fm) < WGM ? (nM - fm) : WGM;
        u.pm = fm + ((wgid % nig) % gsz); u.pn = (wgid % nig) / gsz; return true;
    }
    __device__ __forceinline__ void a_ready(const Unit&) const {}
    __device__ __forceinline__ void done(const Unit&) const {}
};

__device__ __forceinline__ unsigned cvt_pk_bf16(float lo, float hi) { unsigned r; asm volatile("v_cvt_pk_bf16_f32 %0, %1, %2" : "=v"(r) : "v"(lo), "v"(hi)); return r; }
typedef float f32x2 __attribute__((ext_vector_type(2)));
__device__ __forceinline__ f32x2 gelu_pk(f32x2 v) {
    const f32x2 av = __builtin_elementwise_abs(v), d = av * 0.2316418882f + 1.0f;
    f32x2 t; t.x = __builtin_amdgcn_rcpf(d.x); t.y = __builtin_amdgcn_rcpf(d.y);
    f32x2 q = t * 0.5307027145f + (-0.7265760135f); q = q * t + 0.7107068705f; q = q * t + (-0.142248368f); q = q * t + 0.127414796f; q = q * t;
    const f32x2 s = (v * v) * (-0.72134752044f);
    f32x2 e; e.x = __builtin_amdgcn_exp2f(s.x); e.y = __builtin_amdgcn_exp2f(s.y);
    const f32x2 m = v * (q * e), r = v - m;
    f32x2 o; o.x = v.x < 0.f ? m.x : r.x; o.y = v.y < 0.f ? m.y : r.y; return o;
}

template <int ACT  > struct EpiBf16 {
    static constexpr bool PERM = true, AFTER_DRAIN = false; static_assert(ACT == 0 || ACT == 1, "EpiBf16: ACT is 0 (none) or 1 (gelu_pk)");
    bf16_t* O; int ldc; const float* bias; int split_cols; size_t split_stride; float scale0;
    __device__ __forceinline__ void operator()(const f32x4 (&acc)[2][2][4][2], const Unit& u, int wr, int wc, int fr, int fq) const {
        const int row0 = u.pm * BM + wr * 64 + fr; int colt = u.pn * BM; bf16_t* base = O;
        float sc = 1.f; if (split_cols) { const int t = colt / split_cols; base += (size_t)t * split_stride; colt -= t * split_cols; if (t == 0) sc = scale0; }
        const int col0 = colt + wc * 32 + 8 * fq, bcol0 = u.pn * BM + wc * 32 + 8 * fq;
        f32x4 bv[2][2];
#pragma unroll
        for (int bj = 0; bj < 2; ++bj)
#pragma unroll
            for (int n = 0; n < 2; ++n) bv[bj][n] = bias ? *(const f32x4*)(bias + bcol0 + bj * HALF + 4 * n) : (f32x4){0.f, 0.f, 0.f, 0.f};
#pragma unroll
        for (int ai = 0; ai < 2; ++ai)
#pragma unroll
            for (int m = 0; m < 4; ++m) { bf16_t* rowp = base + (size_t)(row0 + ai * HALF + m * 16) * ldc + col0;
#pragma unroll
                for (int bj = 0; bj < 2; ++bj) { f32x4 v0 = acc[ai][bj][m][0] + bv[bj][0], v1 = acc[ai][bj][m][1] + bv[bj][1];
                    if (ACT == 1) { f32x2 a = gelu_pk((f32x2){v0[0], v0[1]}), b = gelu_pk((f32x2){v0[2], v0[3]}), c = gelu_pk((f32x2){v1[0], v1[1]}), d = gelu_pk((f32x2){v1[2], v1[3]});
                        v0 = (f32x4){a.x, a.y, b.x, b.y}; v1 = (f32x4){c.x, c.y, d.x, d.y}; }
                    v0 = v0 * sc; v1 = v1 * sc; u32x4 w; w.x = cvt_pk_bf16(v0[0], v0[1]); w.y = cvt_pk_bf16(v0[2], v0[3]); w.z = cvt_pk_bf16(v1[0], v1[1]); w.w = cvt_pk_bf16(v1[2], v1[3]);
                    *(u32x4*)(rowp + bj * HALF) = w; } }
    }
};
__device__ __forceinline__ float bf2f_(unsigned short h) { return __uint_as_float(((unsigned)h) << 16); }
__device__ __forceinline__ float sigm_(float x) { return __builtin_amdgcn_rcpf(1.f + __expf(-x)); }
__device__ __forceinline__ void unpack8(const u32x4 w, float (&f)[8]) {
    f[0] = __uint_as_float(w.x << 16); f[1] = __uint_as_float(w.x & 0xffff0000u); f[2] = __uint_as_float(w.y << 16); f[3] = __uint_as_float(w.y & 0xffff0000u);
    f[4] = __uint_as_float(w.z << 16); f[5] = __uint_as_float(w.z & 0xffff0000u); f[6] = __uint_as_float(w.w << 16); f[7] = __uint_as_float(w.w & 0xffff0000u);
}
__device__ __forceinline__ u32x4 pack8(const float (&f)[8]) { u32x4 w; w.x = cvt_pk_bf16(f[0], f[1]); w.y = cvt_pk_bf16(f[2], f[3]); w.z = cvt_pk_bf16(f[4], f[5]); w.w = cvt_pk_bf16(f[6], f[7]); return w; }

struct MapOrder {
    StaticOrder so; int latonly;
    __device__ void init(int nMt, int N, int G_, int c_, int lo) { so.init(nMt * BM, N, G_, c_); latonly = lo; }
    __device__ bool next(int i, Unit& u) const { if (!so.next(i, u)) return false; if (latonly == 1) u.pm += 1 + (u.pm >= 64 ? 1 : 0); else if (latonly == 2) u.pm = u.pm ? 65 : 0; return true; }
    __device__ __forceinline__ void a_ready(const Unit&) const {}
    __device__ __forceinline__ void done(const Unit&) const {}
};

struct EpiRoute {
    static constexpr bool PERM = true, AFTER_DRAIN = false, HAS_MID = false;
    bf16_t *Zq, *Zkv, *Zh, *Zu, *Zg;
    __device__ __forceinline__ void operator()(const f32x4 (&acc)[2][2][4][2], const Unit& u, int wr, int wc, int fr, int fq) const {
        asm volatile("" : "+v"(fr), "+v"(fq));
        const int pn = u.pn; bf16_t* base; int ldc, colt;
        if (pn < 2) { base = Zq; ldc = 512; colt = pn * 256; } else if (pn == 2) { base = Zkv; ldc = 256; colt = 0; }
        else if (pn < 8) { base = Zh; ldc = 1280; colt = (pn - 3) * 256; } else if (pn == 8) { base = Zu; ldc = 256; colt = 0; }
        else { base = Zg; ldc = 3072; colt = (pn - 9) * 256; }
        const int row0 = u.pm * BM + wr * 64 + fr, col0 = colt + wc * 32 + 8 * fq;
#pragma unroll
        for (int ai = 0; ai < 2; ++ai)
#pragma unroll
            for (int m = 0; m < 4; ++m) { bf16_t* rowp = base + (size_t)(row0 + ai * HALF + m * 16) * ldc + col0;
#pragma unroll
                for (int bj = 0; bj < 2; ++bj) { const f32x4 v0 = acc[ai][bj][m][0], v1 = acc[ai][bj][m][1];
                    u32x4 w; w.x = cvt_pk_bf16(v0[0], v0[1]); w.y = cvt_pk_bf16(v0[2], v0[3]); w.z = cvt_pk_bf16(v1[0], v1[1]); w.w = cvt_pk_bf16(v1[2], v1[3]);
                    *(u32x4*)(rowp + bj * HALF) = w; } }
    }
};
struct EpiGlu {
    static constexpr bool PERM = true, AFTER_DRAIN = false, HAS_MID = false;
    bf16_t* Ys; const float* bglu; int ld;
    __device__ __forceinline__ void operator()(const f32x4 (&acc)[2][2][4][2], const Unit& u, int wr, int wc, int fr, int fq) const {
        asm volatile("" : "+v"(fr), "+v"(fq));
        const int row0 = u.pm * BM + wr * 64 + fr, col0 = wc * 32 + 8 * fq;
        f32x4 b4[2][2];
#pragma unroll
        for (int bj = 0; bj < 2; ++bj) { b4[bj][0] = *(const f32x4*)(bglu + col0 + bj * HALF); b4[bj][1] = *(const f32x4*)(bglu + col0 + bj * HALF + 4); }
#pragma unroll
        for (int ai = 0; ai < 2; ++ai)
#pragma unroll
            for (int mh = 0; mh < 2; ++mh) { u32x4 zr[2][2];
#pragma unroll
                for (int mm = 0; mm < 2; ++mm)
#pragma unroll
                    for (int bj = 0; bj < 2; ++bj) zr[mm][bj] = *(const u32x4*)(Ys + (size_t)(row0 + ai * HALF + (2 * mh + mm) * 16) * ld + col0 + bj * HALF);
#pragma unroll
                for (int mm = 0; mm < 2; ++mm)
#pragma unroll
                    for (int bj = 0; bj < 2; ++bj) { const int m = 2 * mh + mm; float z[8], o[8]; unpack8(zr[mm][bj], z);
                        const f32x4 v0 = acc[ai][bj][m][0] + b4[bj][0], v1 = acc[ai][bj][m][1] + b4[bj][1];
#pragma unroll
                        for (int i = 0; i < 4; ++i) { o[i] = z[i] * sigm_(v0[i]); o[4 + i] = z[4 + i] * sigm_(v1[i]); }
                        *(u32x4*)(Ys + (size_t)(row0 + ai * HALF + m * 16) * ld + col0 + bj * HALF) = pack8(o); } }
    }
};
template <bool FIRST> struct EpiMerge {
    static constexpr bool PERM = true, AFTER_DRAIN = false, HAS_MID = false;
    bf16_t* m16; const bf16_t* Zg; int gcol;
    __device__ __forceinline__ void operator()(const f32x4 (&acc)[2][2][4][2], const Unit& u, int wr, int wc, int fr, int fq) const {
        asm volatile("" : "+v"(fr), "+v"(fq));
        const int row0 = u.pm * BM + wr * 64 + fr, col0 = u.pn * BM + wc * 32 + 8 * fq;
#pragma unroll
        for (int ai = 0; ai < 2; ++ai)
#pragma unroll
            for (int mh = 0; mh < 2; ++mh) { u32x4 gr[2][2], orr[2][2];
#pragma unroll
                for (int mm = 0; mm < 2; ++mm)
#pragma unroll
                    for (int bj = 0; bj < 2; ++bj) { const size_t r = (size_t)(row0 + ai * HALF + (2 * mh + mm) * 16); const int c = col0 + bj * HALF;
                        gr[mm][bj] = *(const u32x4*)(Zg + r * 3072 + gcol + c); if (!FIRST) orr[mm][bj] = *(const u32x4*)(m16 + r * 1024 + c); }
#pragma unroll
                for (int mm = 0; mm < 2; ++mm)
#pragma unroll
                    for (int bj = 0; bj < 2; ++bj) { const int m = 2 * mh + mm; const size_t r = (size_t)(row0 + ai * HALF + m * 16); const int c = col0 + bj * HALF; float g[8], o[8];
                        unpack8(gr[mm][bj], g);
                        if (FIRST) {
#pragma unroll
                            for (int i = 0; i < 8; ++i) o[i] = 0.f; } else unpack8(orr[mm][bj], o);
                        const f32x4 v0 = acc[ai][bj][m][0], v1 = acc[ai][bj][m][1];
#pragma unroll
                        for (int i = 0; i < 4; ++i) { o[i] += sigm_(g[i]) * v0[i]; o[4 + i] += sigm_(g[4 + i]) * v1[i]; }
                        *(u32x4*)(m16 + r * 1024 + c) = pack8(o); } }
    }
};
struct EpiMerge3 {
    static constexpr bool PERM = true, AFTER_DRAIN = false, HAS_MID = true; static constexpr int MID1 = 8, MID2 = 12;
    bf16_t* m16; const bf16_t* Zg;
    __device__ __forceinline__ void mid(f32x4 (&acc)[2][2][4][2], const Unit& u, int wr, int wc, int fr, int fq, int t) const {
        asm volatile("" : "+v"(fr), "+v"(fq));
        const int gn = (t == MID1) ? 0 : 1024, gd = gn + 1024;
        const int row0 = u.pm * BM + wr * 64 + fr, col0 = u.pn * BM + wc * 32 + 8 * fq;
#pragma unroll
        for (int ai = 0; ai < 2; ++ai)
#pragma unroll
            for (int mh = 0; mh < 1; ++mh) { u32x4 an[4][2], ad[4][2];
#pragma unroll
                for (int mm = 0; mm < 4; ++mm)
#pragma unroll
                    for (int bj = 0; bj < 2; ++bj) { const size_t r = (size_t)(row0 + ai * HALF + (mm) * 16); const int c = col0 + bj * HALF;
                        an[mm][bj] = *(const u32x4*)(Zg + r * 3072 + gn + c); ad[mm][bj] = *(const u32x4*)(Zg + r * 3072 + gd + c); }
#pragma unroll
                for (int mm = 0; mm < 4; ++mm)
#pragma unroll
                    for (int bj = 0; bj < 2; ++bj) { const int m = mm; float a[8], d[8]; unpack8(an[mm][bj], a); unpack8(ad[mm][bj], d);
#pragma unroll
                        for (int i = 0; i < 4; ++i) {
                            acc[ai][bj][m][0][i] *= (1.f + __expf(fminf(-d[i], 80.f))) * __builtin_amdgcn_rcpf(1.f + __expf(fminf(-a[i], 80.f)));
                            acc[ai][bj][m][1][i] *= (1.f + __expf(fminf(-d[4 + i], 80.f))) * __builtin_amdgcn_rcpf(1.f + __expf(fminf(-a[4 + i], 80.f))); } } }
    }
    __device__ __forceinline__ void operator()(const f32x4 (&acc)[2][2][4][2], const Unit& u, int wr, int wc, int fr, int fq) const {
        asm volatile("" : "+v"(fr), "+v"(fq));
        const int row0 = u.pm * BM + wr * 64 + fr, col0 = u.pn * BM + wc * 32 + 8 * fq;
        u32x4 gr[2][4][2];
#pragma unroll
        for (int ai = 0; ai < 2; ++ai)
#pragma unroll
            for (int m = 0; m < 4; ++m)
#pragma unroll
                for (int bj = 0; bj < 2; ++bj) gr[ai][m][bj] = *(const u32x4*)(Zg + (size_t)(row0 + ai * HALF + m * 16) * 3072 + 2048 + col0 + bj * HALF);
#pragma unroll
        for (int ai = 0; ai < 2; ++ai)
#pragma unroll
            for (int m = 0; m < 4; ++m)
#pragma unroll
                for (int bj = 0; bj < 2; ++bj) { float g[8], o[8]; unpack8(gr[ai][m][bj], g); const f32x4 v0 = acc[ai][bj][m][0], v1 = acc[ai][bj][m][1];
#pragma unroll
                    for (int i = 0; i < 4; ++i) { o[i] = sigm_(g[i]) * v0[i]; o[4 + i] = sigm_(g[4 + i]) * v1[i]; }
                    *(u32x4*)(m16 + (size_t)(row0 + ai * HALF + m * 16) * 1024 + col0 + bj * HALF) = pack8(o); }
    }
};
struct EpiResid {
    static constexpr bool PERM = false, AFTER_DRAIN = false, HAS_MID = false;
    const float *src_lat, *src_ctx; float *dst_lat, *dst_ctx; const float* gate;
    __device__ __forceinline__ void operator()(const f32x4 (&acc)[2][2][4][2], const Unit& u, int wr, int wc, int fr, int fq) const {
        asm volatile("" : "+v"(fr), "+v"(fq));
        const int b = u.pm / 65, pt = u.pm % 65; const float* s; float* d; int v;
        if (pt == 0) { s = src_ctx + (size_t)b * 256 * 1024; d = dst_ctx + (size_t)b * 256 * 1024; v = 2; }
        else { const size_t o = ((size_t)b * 16384 + (size_t)(pt - 1) * 256) * 1024; s = src_lat + o; d = dst_lat + o; v = b; }
        const float* gv = gate + v * 6144; const int col0 = u.pn * BM + wc * 32 + 4 * fq;
        f32x4 g4[2][2];
#pragma unroll
        for (int bj = 0; bj < 2; ++bj)
#pragma unroll
            for (int n = 0; n < 2; ++n) g4[bj][n] = *(const f32x4*)(gv + col0 + bj * HALF + n * 16);
#pragma unroll
        for (int ai = 0; ai < 2; ++ai)
#pragma unroll
            for (int mh = 0; mh < 2; ++mh) { f32x4 x[2][2][2];
#pragma unroll
                for (int mm = 0; mm < 2; ++mm)
#pragma unroll
                    for (int bj = 0; bj < 2; ++bj)
#pragma unroll
                        for (int n = 0; n < 2; ++n) x[mm][bj][n] = *(const f32x4*)(s + (size_t)(ai * HALF + wr * 64 + (2 * mh + mm) * 16 + fr) * 1024 + col0 + bj * HALF + n * 16);
#pragma unroll
                for (int mm = 0; mm < 2; ++mm)
#pragma unroll
                    for (int bj = 0; bj < 2; ++bj)
#pragma unroll
                        for (int n = 0; n < 2; ++n) *(f32x4*)(d + (size_t)(ai * HALF + wr * 64 + (2 * mh + mm) * 16 + fr) * 1024 + col0 + bj * HALF + n * 16) = x[mm][bj][n] + g4[bj][n] * acc[ai][bj][2 * mh + mm][n]; }
    }
};
struct EpiPart {
    static constexpr bool PERM = false, AFTER_DRAIN = false, HAS_MID = false;
    float* P; const float* gate;
    __device__ __forceinline__ void operator()(const f32x4 (&acc)[2][2][4][2], const Unit& u, int wr, int wc, int fr, int fq) const {
        asm volatile("" : "+v"(fr), "+v"(fq));
        float* d = P + (size_t)(u.pm ? 256 : 0) * 1024; const int col0 = u.pn * BM + wc * 32 + 4 * fq;
#pragma unroll
        for (int bj = 0; bj < 2; ++bj)
#pragma unroll
            for (int n = 0; n < 2; ++n) { const f32x4 g4 = *(const f32x4*)(gate + col0 + bj * HALF + n * 16);
#pragma unroll
                for (int ai = 0; ai < 2; ++ai)
#pragma unroll
                    for (int m = 0; m < 4; ++m) *(f32x4*)(d + (size_t)(ai * HALF + wr * 64 + m * 16 + fr) * 1024 + col0 + bj * HALF + n * 16) = g4 * acc[ai][bj][m][n]; }
    }
};
struct EpiSwiglu {
    static constexpr bool PERM = true, AFTER_DRAIN = false, HAS_MID = false;
    bf16_t* Hid;
    __device__ __forceinline__ void operator()(const f32x4 (&acc)[2][2][4][2], const Unit& u, int wr, int wc, int fr, int fq) const {
        asm volatile("" : "+v"(fr), "+v"(fq));
        const int row0 = u.pm * BM + wr * 64 + fr, col0 = u.pn * HALF + wc * 32 + 8 * fq;
#pragma unroll
        for (int ai = 0; ai < 2; ++ai)
#pragma unroll
            for (int m = 0; m < 4; ++m) { float o[8]; const f32x4 a0 = acc[ai][0][m][0], a1 = acc[ai][0][m][1], b0 = acc[ai][1][m][0], b1 = acc[ai][1][m][1];
#pragma unroll
                for (int i = 0; i < 4; ++i) { o[i] = a0[i] * sigm_(a0[i]) * b0[i]; o[4 + i] = a1[i] * sigm_(a1[i]) * b1[i]; }
                *(u32x4*)(Hid + (size_t)(row0 + ai * HALF + m * 16) * 2816 + col0) = pack8(o); }
    }
};
template <class Epi, class Sched, bool ALIGN_EPI = false, bool SP2 = false>
__device__ __forceinline__ void gemm_phase(PG8_LAS unsigned char* lds, const Gemm g, const Sched& S, const Epi& E, int wave_in) {
    int lane_ = lane_id_fresh(); asm volatile("" : "+s"(wave_in));
    const int tid = wave_in * 64 + lane_, wid = __builtin_amdgcn_readfirstlane(tid >> 6), lane = tid & 63, wr = wid >> 2, wc = wid & 3, fr = lane & 15, fq = lane >> 4;
    const int K = g.K, nt = K / BK, lda_ = g.lda ? g.lda : g.K, ldb_ = g.ldb ? g.ldb : g.K;
    unsigned voffA[2], voffB[2];
#pragma unroll
    for (int i = 0; i < 2; ++i) { int R, C; stage_rc(tid * 16 + i * 8192, R, C); const int Rb = Epi::PERM ? ((R & ~31) + perm32(R & 31)) : R;
        voffA[i] = (unsigned)(R * lda_ + C) * 2u; voffB[i] = (unsigned)(Rb * ldb_ + C) * 2u; }
    const size_t kstep = (size_t)(BK * 2);
    const size_t hstep = (size_t)HALF * ldb_ * 2;
    const size_t tstep = 2 * hstep;
    const size_t hstepA = (size_t)HALF * lda_ * 2, tstepA = 2 * hstepA;
    const unsigned ldsw = (unsigned)wid * 1024u;
    const int aoff = lds_byte(wr * 64 + fr, fq * 8), boff = lds_byte(wc * 32 + fr, fq * 8);
#define PG8_SA(b, h) (((b) * 2 + (h)) * HTB)
#define PG8_SB(b, h) ((4 + (b) * 2 + (h)) * HTB)
#define PG8_STAGE(bufoff, gbase, voff) do { _Pragma("unroll") for (int _i = 0; _i < 2; ++_i) \
        __builtin_amdgcn_global_load_lds((const unsigned*)((const char*)(gbase) + (voff)[_i]), (PG8_LAS unsigned*)(lds + (bufoff) + ldsw + _i * 8192), 16, 0, 0); } while (0)
#define PG8_LDA(dst, b, h) do { _Pragma("unroll") for (int m = 0; m < 4; ++m) _Pragma("unroll") for (int k = 0; k < 2; ++k) dst[m][k] = *(const PG8_LAS bf16x8*)(lds + PG8_SA(b, h) + aoff + m * 2048 + k * 1024); } while (0)
#define PG8_LDB(dst, b, h) do { _Pragma("unroll") for (int n = 0; n < 2; ++n) _Pragma("unroll") for (int k = 0; k < 2; ++k) dst[n][k] = *(const PG8_LAS bf16x8*)(lds + PG8_SB(b, h) + boff + n * 2048 + k * 1024); } while (0)
#define PG8_MMA(ai, bj, At, Bt) do { __builtin_amdgcn_s_setprio(1); _Pragma("unroll") for (int m = 0; m < 4; ++m) _Pragma("unroll") for (int n = 0; n < 2; ++n) _Pragma("unroll") for (int k = 0; k < 2; ++k) \
        acc[ai][bj][m][n] = __builtin_amdgcn_mfma_f32_16x16x32_bf16(Bt[n][k], At[m][k], acc[ai][bj][m][n], 0, 0, 0); __builtin_amdgcn_s_setprio(0); } while (0)
#define PG8_WAIT_V(n) asm volatile("s_waitcnt vmcnt(" #n ")" ::: "memory")
#define PG8_WAIT_L(n) asm volatile("s_waitcnt lgkmcnt(" #n ")" ::: "memory")
#define PG8_BAR __builtin_amdgcn_s_barrier()
#define PG8_SCHED __builtin_amdgcn_sched_barrier(0)
    Unit cur, nxt; int ui = 0;
    if (!S.next(0, cur)) return;
    f32x4 acc[2][2][4][2];
#pragma unroll
    for (int a = 0; a < 2; ++a)
#pragma unroll
        for (int b = 0; b < 2; ++b)
#pragma unroll
            for (int m = 0; m < 4; ++m)
#pragma unroll
                for (int n = 0; n < 2; ++n) acc[a][b][m][n] = (f32x4){0.f, 0.f, 0.f, 0.f};
    bf16x8 At[4][2], B0[2][2], B1[2][2];
    const char* cA = (const char*)g.A + (size_t)cur.pm * tstepA; const char* cB = (const char*)g.Bt + (size_t)cur.pn * tstep;
    S.a_ready(cur);
    if constexpr (SP2) {
        PG8_STAGE(PG8_SB(0, 0), cB, voffB); PG8_STAGE(PG8_SB(0, 1), cB + hstep, voffB); PG8_STAGE(PG8_SA(0, 0), cA, voffA); PG8_STAGE(PG8_SA(0, 1), cA + hstepA, voffA);
        if (wr == 1) PG8_BAR;
        PG8_WAIT_V(2); PG8_BAR;
        PG8_STAGE(PG8_SB(1, 0), cB + kstep, voffB); PG8_STAGE(PG8_SA(1, 0), cA + kstep, voffA); PG8_STAGE(PG8_SB(1, 1), cB + hstep + kstep, voffB);
        PG8_WAIT_V(6); PG8_BAR;
    } else {
        PG8_STAGE(PG8_SB(0, 0), cB, voffB); PG8_STAGE(PG8_SA(0, 0), cA, voffA); PG8_STAGE(PG8_SB(0, 1), cB + hstep, voffB); PG8_STAGE(PG8_SA(0, 1), cA + hstepA, voffA);
        if (wr == 1) PG8_BAR;
        PG8_WAIT_V(4); PG8_BAR;
        PG8_STAGE(PG8_SB(1, 0), cB + kstep, voffB); PG8_STAGE(PG8_SA(1, 0), cA + kstep, voffA); PG8_STAGE(PG8_SB(1, 1), cB + hstep + kstep, voffB);
        PG8_WAIT_V(6); PG8_BAR;
    }
    for (;;) {
        const bool has_next = S.next(ui + 1, nxt);
        const char* nA = has_next ? (const char*)g.A + (size_t)nxt.pm * tstepA : cA; const char* nB = has_next ? (const char*)g.Bt + (size_t)nxt.pn * tstep : cB;
        for (int t = 0; t < nt; t += 2) {
            if constexpr (Epi::HAS_MID) { if (t == Epi::MID1 || t == Epi::MID2) E.mid(acc, cur, wr, wc, fr, fq, t); }
            const bool last = (t == nt - 2);
            const char* a1 = cA + (size_t)(t + 1) * kstep;
            const char* a2 = last ? nA : cA + (size_t)(t + 2) * kstep; const char* b2 = last ? nB : cB + (size_t)(t + 2) * kstep;
            const char* a3 = a2 + kstep; const char* b3 = b2 + kstep;
            if (last && has_next) S.a_ready(nxt);
            if constexpr (SP2) {
            PG8_LDB(B0, 0, 0); PG8_LDB(B1, 0, 1); PG8_SCHED; PG8_LDA(At, 0, 0); PG8_STAGE(PG8_SA(1, 1), a1 + hstepA, voffA);
            PG8_WAIT_V(8); PG8_WAIT_L(0); PG8_BAR; PG8_MMA(0, 0, At, B0); PG8_MMA(0, 1, At, B1); PG8_BAR; PG8_SCHED;
            PG8_LDA(At, 0, 1); PG8_STAGE(PG8_SB(0, 0), b2, voffB); PG8_STAGE(PG8_SB(0, 1), b2 + hstep, voffB); PG8_STAGE(PG8_SA(0, 0), a2, voffA);
            PG8_WAIT_V(8); PG8_WAIT_L(0); PG8_BAR; PG8_MMA(1, 0, At, B0); PG8_MMA(1, 1, At, B1); PG8_BAR; PG8_SCHED;
            PG8_LDB(B0, 1, 0); PG8_LDB(B1, 1, 1); PG8_SCHED; PG8_LDA(At, 1, 0); PG8_STAGE(PG8_SA(0, 1), a2 + hstepA, voffA);
            PG8_WAIT_V(8); PG8_WAIT_L(0); PG8_BAR; PG8_MMA(0, 0, At, B0); PG8_MMA(0, 1, At, B1); PG8_BAR; PG8_SCHED;
            PG8_LDA(At, 1, 1); PG8_STAGE(PG8_SB(1, 0), b3, voffB); PG8_STAGE(PG8_SB(1, 1), b3 + hstep, voffB); PG8_STAGE(PG8_SA(1, 0), a3, voffA);
            PG8_WAIT_V(8); PG8_WAIT_L(0); PG8_BAR; PG8_MMA(1, 0, At, B0); PG8_MMA(1, 1, At, B1); PG8_BAR; PG8_SCHED;
            } else {
            PG8_LDB(B0, 0, 0); PG8_SCHED; PG8_LDA(At, 0, 0); PG8_STAGE(PG8_SA(1, 1), a1 + hstepA, voffA);
            PG8_WAIT_L(8); PG8_BAR; PG8_WAIT_L(0); PG8_MMA(0, 0, At, B0); PG8_BAR; PG8_SCHED;
            PG8_LDB(B1, 0, 1); PG8_STAGE(PG8_SB(0, 0), b2, voffB);
            PG8_BAR; PG8_WAIT_L(0); PG8_MMA(0, 1, At, B1); PG8_BAR;
            PG8_LDA(At, 0, 1); PG8_STAGE(PG8_SA(0, 0), a2, voffA);
            PG8_BAR; PG8_WAIT_L(0); PG8_MMA(1, 0, At, B0); PG8_BAR; PG8_SCHED;
            PG8_STAGE(PG8_SB(0, 1), b2 + hstep, voffB);
            PG8_WAIT_V(6); PG8_BAR; PG8_MMA(1, 1, At, B1); PG8_BAR;
            PG8_LDB(B0, 1, 0); PG8_SCHED; PG8_LDA(At, 1, 0); PG8_STAGE(PG8_SA(0, 1), a2 + hstepA, voffA);
            PG8_WAIT_L(8); PG8_BAR; PG8_WAIT_L(0); PG8_MMA(0, 0, At, B0); PG8_BAR; PG8_SCHED;
            PG8_LDB(B1, 1, 1); PG8_STAGE(PG8_SB(1, 0), b3, voffB);
            PG8_BAR; PG8_WAIT_L(0); PG8_MMA(0, 1, At, B1); PG8_BAR;
            PG8_LDA(At, 1, 1); PG8_STAGE(PG8_SA(1, 0), a3, voffA);
            PG8_BAR; PG8_WAIT_L(0); PG8_MMA(1, 0, At, B0); PG8_BAR; PG8_SCHED;
            PG8_STAGE(PG8_SB(1, 1), b3 + hstep, voffB);
            PG8_WAIT_V(6); PG8_BAR; PG8_MMA(1, 1, At, B1); PG8_BAR;
            }
        }
        if constexpr (ALIGN_EPI) { if (wr == 0) PG8_BAR; }
        if constexpr (!Epi::AFTER_DRAIN) { E(acc, cur, wr, wc, fr, fq); S.done(cur); }
        if (!has_next) break;
#pragma unroll
        for (int a = 0; a < 2; ++a)
#pragma unroll
            for (int b = 0; b < 2; ++b)
#pragma unroll
                for (int m = 0; m < 4; ++m)
#pragma unroll
                    for (int n = 0; n < 2; ++n) acc[a][b][m][n] = (f32x4){0.f, 0.f, 0.f, 0.f};
        cur = nxt; cA = nA; cB = nB; ++ui;
        if constexpr (ALIGN_EPI) { if (wr == 1) PG8_BAR; }
    }
    PG8_WAIT_V(0);
    if constexpr (!ALIGN_EPI) { if (wr == 0) PG8_BAR; }
    PG8_BAR;
    if constexpr (Epi::AFTER_DRAIN) { E.fused(acc, cur, wr, wc, fr, fq, lds, wid, lane); S.done(cur); }
#undef PG8_SA
#undef PG8_SB
#undef PG8_STAGE
#undef PG8_LDA
#undef PG8_LDB
#undef PG8_MMA
#undef PG8_WAIT_V
#undef PG8_WAIT_L
#undef PG8_BAR
#undef PG8_SCHED
}
}
#include <hip/hip_bf16.h>
#include <cmath>
namespace attn_body {
using bf16=__hip_bfloat16;
using bf16x8=__attribute__((ext_vector_type(8)))short;
using s16x4=__attribute__((ext_vector_type(4)))short;
using f32x16=__attribute__((ext_vector_type(16)))float;
using u32x4=__attribute__((ext_vector_type(4)))unsigned;
constexpr int D=64,QP=512,KP=256,OP=1024;
constexpr int NW=8,QBLK=32,QB=QBLK*NW,KVBLK=64;
constexpr int ATTN_UNIT_ROWS=QB;
__device__ __forceinline__ int crow(int r,int hi){return (r&3)+8*(r>>2)+4*hi;}
#define SBAR() __builtin_amdgcn_sched_barrier(0)
__device__ __forceinline__ void cmask(f32x16&p0,f32x16&p1,int jb,int qrel,int hi){
  const float NEG=-INFINITY; int kb=64*jb+4*hi;
  #pragma unroll
  for(int r=0;r<16;++r){int kv=kb+(r&3)+8*(r>>2); if(kv>qrel)p0[r]=NEG; if(kv+32>qrel)p1[r]=NEG;}
}

constexpr int NSLOT=3, SLOTB=8192;
constexpr int LDS_K=0, LDS_V=NSLOT*SLOTB, LDS_WS=2*NSLOT*SLOTB, LDS_OST=LDS_WS+NW*64*4, LDS_BYTES=LDS_OST+NW*4096;
constexpr float C2=0.125f*1.4426950408889634f;
__device__ __forceinline__ void glds16(const void*gsrc,unsigned lds_dst){unsigned keep;
  asm volatile("s_mov_b32 %0, m0\n\ts_mov_b32 m0, %2\n\ts_nop 0\n\tglobal_load_lds_dwordx4 %1, off\n\ts_mov_b32 m0, %0":"=&s"(keep):"v"(gsrc),"s"(lds_dst):"memory");}
__device__ __forceinline__ float max3f(float a,float b,float c){float r;asm("v_max3_f32 %0, %1, %2, %3":"=v"(r):"v"(a),"v"(b),"v"(c));return r;}
__device__ __forceinline__ float max2f(float a,float b){float r;asm("v_max_f32_e32 %0, %1, %2":"=v"(r):"v"(a),"v"(b));return r;}
__device__ __forceinline__ float fadd_s(float a,float b){float r;asm("v_add_f32_e32 %0, %1, %2":"=v"(r):"v"(a),"v"(b));return r;}
__device__ __forceinline__ float fsub_s(float a,float b){float r;asm("v_sub_f32_e32 %0, %1, %2":"=v"(r):"v"(a),"v"(b));return r;}
typedef float f32x2_t __attribute__((ext_vector_type(2))); typedef __bf16 bf16x2_t __attribute__((ext_vector_type(2)));
__device__ __forceinline__ unsigned cvtpk_s(float lo,float hi){f32x2_t v={lo,hi};bf16x2_t b=__builtin_convertvector(v,bf16x2_t);return __builtin_bit_cast(unsigned,b);}
#define WAIT_BAR(N) asm volatile("s_waitcnt vmcnt(" #N ") lgkmcnt(0)\n\ts_barrier":::"memory")

__device__ __forceinline__ void qkt(f32x16&p0,f32x16&p1,const char*Kslot,const bf16x8*qr,const f32x16&negm,int r32,int hi){
  const char*kb=Kslot+hi*1024+r32*16;
  #pragma unroll
  for(int d0=0;d0<4;++d0){
    const bf16x8 b0=*reinterpret_cast<const bf16x8*>(kb+d0*2048);
    const bf16x8 b1=*reinterpret_cast<const bf16x8*>(kb+d0*2048+512);
    if(d0==0){p0=__builtin_amdgcn_mfma_f32_32x32x16_bf16(b0,qr[0],negm,0,0,0);p1=__builtin_amdgcn_mfma_f32_32x32x16_bf16(b1,qr[0],negm,0,0,0);}
    else{p0=__builtin_amdgcn_mfma_f32_32x32x16_bf16(b0,qr[d0],p0,0,0,0);p1=__builtin_amdgcn_mfma_f32_32x32x16_bf16(b1,qr[d0],p1,0,0,0);}}
}
typedef __attribute__((address_space(3))) const char* lds_cptr;
typedef short v4i16_t __attribute__((ext_vector_type(4)));
__device__ __forceinline__ void kload8(bf16x8*kf,lds_cptr kp){
  kf[0]=*(const __attribute__((address_space(3))) bf16x8*)(kp);      kf[1]=*(const __attribute__((address_space(3))) bf16x8*)(kp+512);
  kf[2]=*(const __attribute__((address_space(3))) bf16x8*)(kp+2048); kf[3]=*(const __attribute__((address_space(3))) bf16x8*)(kp+2560);
  kf[4]=*(const __attribute__((address_space(3))) bf16x8*)(kp+4096); kf[5]=*(const __attribute__((address_space(3))) bf16x8*)(kp+4608);
  kf[6]=*(const __attribute__((address_space(3))) bf16x8*)(kp+6144); kf[7]=*(const __attribute__((address_space(3))) bf16x8*)(kp+6656);
}
__device__ __forceinline__ void kload2(bf16x8*kf,lds_cptr kp,int j){ kf[2*j]=*(const __attribute__((address_space(3))) bf16x8*)(kp+j*2048); kf[2*j+1]=*(const __attribute__((address_space(3))) bf16x8*)(kp+j*2048+512); }
__device__ __forceinline__ s16x4 vtr(lds_cptr p){ return __builtin_bit_cast(s16x4,__builtin_amdgcn_ds_read_tr16_b64_v4i16((__attribute__((address_space(3))) v4i16_t*)p)); }
__device__ __forceinline__ float rowmax(const f32x16&p0,const f32x16&p1){
  float a=max3f(p0[0],p0[1],p1[0]),b=max3f(p0[2],p0[3],p1[1]);a=max3f(a,p1[2],p1[3]);
  #pragma unroll
  for(int r=4;r<16;r+=4){a=max3f(a,p0[r],p0[r+1]);b=max3f(b,p0[r+2],p0[r+3]);a=max3f(a,p1[r],p1[r+1]);b=max3f(b,p1[r+2],p1[r+3]);}
  const float m=max2f(a,b);
  auto rr=__builtin_amdgcn_permlane32_swap(__float_as_uint(m),__float_as_uint(m),false,false);
  return max2f(__uint_as_float(rr[0]),__uint_as_float(rr[1]));
}
__device__ __forceinline__ void pv(f32x16*o,int vb,bf16x8 pa0,bf16x8 pa1,bf16x8 pa2,bf16x8 pa3){
  #pragma unroll
  for(int d0=0;d0<2;++d0){s16x4 lo[4],hi[4];
    #pragma unroll
    for(int ks=0;ks<4;++ks){
      asm volatile("ds_read_b64_tr_b16 %0,%1 offset:%c2":"=&v"(lo[ks]):"v"(vb),"i"(d0*4096+ks*1024):"memory");
      asm volatile("ds_read_b64_tr_b16 %0,%1 offset:%c2":"=&v"(hi[ks]):"v"(vb),"i"(d0*4096+ks*1024+512):"memory");}
    asm volatile("s_waitcnt lgkmcnt(0)":::"memory");SBAR();
    #define PK(k) (bf16x8){lo[k][0],lo[k][1],lo[k][2],lo[k][3],hi[k][0],hi[k][1],hi[k][2],hi[k][3]}
    o[d0]=__builtin_amdgcn_mfma_f32_32x32x16_bf16(pa0,PK(0),o[d0],0,0,0);
    o[d0]=__builtin_amdgcn_mfma_f32_32x32x16_bf16(pa1,PK(1),o[d0],0,0,0);
    o[d0]=__builtin_amdgcn_mfma_f32_32x32x16_bf16(pa2,PK(2),o[d0],0,0,0);
    o[d0]=__builtin_amdgcn_mfma_f32_32x32x16_bf16(pa3,PK(3),o[d0],0,0,0);
    #undef PK
  }
}

#ifndef ATTN_STORE16
#define ATTN_STORE16(p,v) (*(u32x4*)(p)=(v))
#endif
template<int THRL,bool FIXM> __device__ __forceinline__ void attn_unit(float mfix,long rowbase,int q0,int NT,int h,int hk,const bf16*Q,const bf16*__restrict__ K,const bf16*__restrict__ V,bf16*O,char*shm,int tid_in){
  int lane_=lane_id_fresh(); asm volatile("":"+s"(tid_in)); const int tid=tid_in*64+lane_,lane=tid&63,r32=lane&31,hi=lane>>5; const int wid=__builtin_amdgcn_readfirstlane(tid>>6);
  const bf16*Qw=Q+(rowbase+q0+wid*QBLK)*QP+h*D;
  const bf16*Kh=K+rowbase*KP+hk*D,*Vh=V+rowbase*KP+hk*D;
  const unsigned lds0=(unsigned)(uintptr_t)shm;
  float*wsf=(float*)(shm+LDS_WS)+wid*64;
  const bf16*ksrc=Kh+(long)lane*KP+wid*8;
  const bf16*vsrc=Vh+(long)(16*(wid&3)+(lane>>2))*KP+(wid>>2)*32+(lane&3)*8;
  const unsigned kdst=lds0+LDS_K+wid*1024, vdst=lds0+LDS_V+wid*1024;
  #define DMA_K(t,slot) glds16(ksrc+(long)(t)*KVBLK*KP,(unsigned)__builtin_amdgcn_readfirstlane(kdst+(slot)))
  #define DMA_V(t,slot) glds16(vsrc+(long)(t)*KVBLK*KP,(unsigned)__builtin_amdgcn_readfirstlane(vdst+(slot)))
  const int vb0=(int)(lds0+LDS_V)+((lane>>4)&1)*32+(lane&3)*8+(4*hi+((lane&15)>>2))*64;
  const char*Kbase=shm+LDS_K; bf16x8 kf[8];
  const lds_cptr shm3=(lds_cptr)shm; const lds_cptr kp0=shm3+LDS_K+hi*1024+r32*16; const lds_cptr vp0=shm3+LDS_V+((lane>>4)&1)*32+(lane&3)*8+(4*hi+((lane&15)>>2))*64;
  DMA_K(0,0);DMA_V(0,0);DMA_K(1,SLOTB);
  bf16x8 qr[4];
  #pragma unroll
  for(int d0=0;d0<4;++d0)qr[d0]=*reinterpret_cast<const bf16x8*>(&Qw[(long)r32*QP+d0*16+hi*8]);
  float mhat=0.f,l_reg=0.f;f32x16 o[2];o[0]=f32x16{};o[1]=f32x16{};f32x16 negm=f32x16{};asm volatile("":"+v"(negm));
  #define CMASK(P0,P1,t) do{}while(0)
  bool resc=false;
  #define START(P0,P1) do{ const float rm=FIXM?mfix:rowmax(P0,P1); resc=false; \
    { const float dl=rm; mhat=fadd_s(mhat,dl); \
      _Pragma("unroll") for(int r=0;r<16;++r){P0[r]=fsub_s(P0[r],dl);P1[r]=fsub_s(P1[r],dl);} \
      _Pragma("unroll") for(int r=0;r<16;++r)negm[r]=-mhat; asm volatile("":"+v"(negm)); } \
    _Pragma("unroll") for(int r=0;r<16;++r)P0[r]=__builtin_amdgcn_exp2f(P0[r]); }while(0)
  #define RESC() do{ if(resc){ asm volatile("s_waitcnt lgkmcnt(0)":::"memory"); \
      _Pragma("unroll") for(int d_=0;d_<2;++d_) _Pragma("unroll") for(int r=0;r<16;++r)o[d_][r]*=wsf[crow(r,hi)]; } }while(0)
  f32x16 pA0,pA1,pB0,pB1;
  int sl_prev=0,sl_cur=0,sl_next=SLOTB;
  #define ROT() do{sl_prev=sl_cur;sl_cur=sl_next;sl_next=(sl_next==(NSLOT-1)*SLOTB)?0:sl_next+SLOTB;}while(0)
  DMA_K(2,2*SLOTB);
  WAIT_BAR(3);
  qkt(pA0,pA1,Kbase,qr,negm,r32,hi);asm volatile("s_nop 15\n\ts_nop 7":"+v"(pA0),"+v"(pA1));CMASK(pA0,pA1,0);
  START(pA0,pA1);
  _Pragma("unroll") for(int r=0;r<16;++r)pA1[r]=__builtin_amdgcn_exp2f(pA1[r]);
  WAIT_BAR(0);
  DMA_K(3,0);DMA_V(1,SLOTB);
  ROT();
  kload8(kf,kp0+sl_cur);
  WAIT_BAR(2);
  s16x4 vlo[8],vhi[8]; u32x4 pw0,pw1,pw2,pw3;
  #define PKW(P,B) cvtpk_s(P[B],P[B+1])
  #define PAF(k) __builtin_bit_cast(bf16x8,pw##k)
  #define VFR(i) (bf16x8){vlo[i][0],vlo[i][1],vlo[i][2],vlo[i][3],vhi[i][0],vhi[i][1],vhi[i][2],vhi[i][3]}
  #define PIN(x) asm volatile("":"+v"(x))
  #define MX3(a,b,c) __builtin_fmaxf(__builtin_fmaxf((a),(b)),(c))
  #define GAPA(MF,A0,A1,A2,A3,W0,W1,PW) do{ MF; sacc+=A0; sacc+=A1; sacc+=A2; sacc+=A3; PIN(sacc); W0; W1; PIN(PW); SBAR(); }while(0)
  #define EX(v) __builtin_amdgcn_exp2f(v)
  #define GAPB(MF,X,B) do{ MF; X[B]=EX(X[B]); X[B+1]=EX(X[B+1]); X[B+2]=EX(X[B+2]); X[B+3]=EX(X[B+3]); PIN(X); SBAR(); }while(0)
  #define VRD(i) do{ vlo[i]=vtr(vp_+(((i)>>2)*4096+((i)&3)*1024)); vhi[i]=vtr(vp_+(((i)>>2)*4096+((i)&3)*1024+512)); }while(0)
  #define KRD(G,j) do{ if(G){ kload2(kf,kp0+sl_next,j); SBAR(); } }while(0)
  #define STEP(C0,C1,P0,P1,t,GK,GV,GL) do{ SBAR(); \
    const lds_cptr vp_=vp0+sl_prev; \
    VRD(0); SBAR(); float sacc=(P0[0]+P0[1]); \
    GAPA(C0=__builtin_amdgcn_mfma_f32_32x32x16_bf16(kf[0],qr[0],negm,0,0,0), P0[2],P0[3],P0[4],P0[5],     pw0[0]=PKW(P0,0), pw0[1]=PKW(P0,2), pw0); \
    VRD(4); SBAR(); GAPA(C1=__builtin_amdgcn_mfma_f32_32x32x16_bf16(kf[1],qr[0],negm,0,0,0), P0[6],P0[7],P0[8],P0[9],     pw0[2]=PKW(P0,4), pw0[3]=PKW(P0,6), pw0); \
    VRD(1); SBAR(); GAPA(C0=__builtin_amdgcn_mfma_f32_32x32x16_bf16(kf[2],qr[1],C0,0,0,0),   P0[10],P0[11],P0[12],P0[13], pw1[0]=PKW(P0,8), pw1[1]=PKW(P0,10), pw1); \
    VRD(5); SBAR(); GAPA(C1=__builtin_amdgcn_mfma_f32_32x32x16_bf16(kf[3],qr[1],C1,0,0,0),   P0[14],P0[15],P1[0],P1[1],   pw1[2]=PKW(P0,12),pw1[3]=PKW(P0,14), pw1); \
    VRD(2); SBAR(); GAPA(C0=__builtin_amdgcn_mfma_f32_32x32x16_bf16(kf[4],qr[2],C0,0,0,0),   P1[2],P1[3],P1[4],P1[5],     pw2[0]=PKW(P1,0), pw2[1]=PKW(P1,2), pw2); \
    VRD(6); SBAR(); GAPA(C1=__builtin_amdgcn_mfma_f32_32x32x16_bf16(kf[5],qr[2],C1,0,0,0),   P1[6],P1[7],P1[8],P1[9],     pw2[2]=PKW(P1,4), pw2[3]=PKW(P1,6), pw2); \
    VRD(3); SBAR(); GAPA(C0=__builtin_amdgcn_mfma_f32_32x32x16_bf16(kf[6],qr[3],C0,0,0,0),   P1[10],P1[11],P1[12],P1[13], pw3[0]=PKW(P1,8), pw3[1]=PKW(P1,10), pw3); \
    VRD(7); SBAR(); GAPA(C1=__builtin_amdgcn_mfma_f32_32x32x16_bf16(kf[7],qr[3],C1,0,0,0),   P1[14],P1[15],0.f,0.f,       pw3[2]=PKW(P1,12),pw3[3]=PKW(P1,14), pw3); \
    l_reg+=sacc; \
    if(GK){DMA_K((t)+3,sl_cur);} if(GV){DMA_V((t)+1,sl_next);} \
    CMASK(C0,C1,t); \
    if(!FIXM){ float a=MX3(C0[0],C0[1],C1[0]),b=MX3(C0[2],C0[3],C1[1]); a=MX3(a,C1[2],C1[3]); \
      _Pragma("unroll") for(int r=4;r<16;r+=4){a=MX3(a,C0[r],C0[r+1]);b=MX3(b,C0[r+2],C0[r+3]);a=MX3(a,C1[r],C1[r+1]);b=MX3(b,C1[r+2],C1[r+3]);} \
      float rm=__builtin_fmaxf(a,b); { auto rr=__builtin_amdgcn_permlane32_swap(__float_as_uint(rm),__float_as_uint(rm),false,false); rm=__builtin_fmaxf(__uint_as_float(rr[0]),__uint_as_float(rr[1])); } \
      resc=false; \
      if(__builtin_expect(__any(rm>(float)THRL),0)){ const float dl=__builtin_fmaxf(rm,0.f); mhat+=dl; \
        _Pragma("unroll") for(int r=0;r<16;++r){C0[r]-=dl;C1[r]-=dl;} \
        _Pragma("unroll") for(int r=0;r<16;++r)negm[r]=-mhat; asm volatile("":"+v"(negm)); \
        const float f=__builtin_amdgcn_exp2f(-dl); l_reg*=f; if(hi==0)wsf[r32]=f; resc=true; } } \
    SBAR(); \
    GAPB(o[0]=__builtin_amdgcn_mfma_f32_32x32x16_bf16(PAF(0),VFR(0),o[0],0,0,0), C0,0); \
    GAPB(o[1]=__builtin_amdgcn_mfma_f32_32x32x16_bf16(PAF(0),VFR(4),o[1],0,0,0), C0,4); \
    KRD(GL,0); GAPB(o[0]=__builtin_amdgcn_mfma_f32_32x32x16_bf16(PAF(1),VFR(1),o[0],0,0,0), C0,8); \
    KRD(GL,1); GAPB(o[1]=__builtin_amdgcn_mfma_f32_32x32x16_bf16(PAF(1),VFR(5),o[1],0,0,0), C0,12); \
    KRD(GL,2); GAPB(o[0]=__builtin_amdgcn_mfma_f32_32x32x16_bf16(PAF(2),VFR(2),o[0],0,0,0), C1,0); \
    KRD(GL,3); GAPB(o[1]=__builtin_amdgcn_mfma_f32_32x32x16_bf16(PAF(2),VFR(6),o[1],0,0,0), C1,4); \
    GAPB(o[0]=__builtin_amdgcn_mfma_f32_32x32x16_bf16(PAF(3),VFR(3),o[0],0,0,0), C1,8); \
    GAPB(o[1]=__builtin_amdgcn_mfma_f32_32x32x16_bf16(PAF(3),VFR(7),o[1],0,0,0), C1,12); \
    }while(0)
  int t=1;
  #undef CMASK
  #define CMASK(P0,P1,t) do{}while(0)
  for(;t+5<NT;t+=2){
    STEP(pB0,pB1,pA0,pA1,t,true,true,true);     WAIT_BAR(2); RESC(); ROT();
    STEP(pA0,pA1,pB0,pB1,t+1,true,true,true);   WAIT_BAR(2); RESC(); ROT();
  }
  #undef CMASK
  #define CMASK(P0,P1,t) do{}while(0)
  #define ENDW(tt) do{ if((tt)+3<NT){WAIT_BAR(2);} else if((tt)+2<NT){WAIT_BAR(1);} else {WAIT_BAR(0);} }while(0)
  for(;t+1<NT;t+=2){
    STEP(pB0,pB1,pA0,pA1,t,(t+3<NT),(t+1<NT),(t+1<NT));       ENDW(t);   RESC(); ROT();
    STEP(pA0,pA1,pB0,pB1,t+1,(t+4<NT),(t+2<NT),(t+2<NT));     ENDW(t+1); RESC(); ROT();
  }
  STEP(pB0,pB1,pA0,pA1,NT-1,false,false,false); RESC();
  { float sacc=pB0[0]+pB0[1]; _Pragma("unroll") for(int r=2;r<16;++r)sacc+=pB0[r]; _Pragma("unroll") for(int r=0;r<16;++r)sacc+=pB1[r]; l_reg+=sacc;
    pw0=(u32x4){PKW(pB0,0),PKW(pB0,2),PKW(pB0,4),PKW(pB0,6)};pw1=(u32x4){PKW(pB0,8),PKW(pB0,10),PKW(pB0,12),PKW(pB0,14)};pw2=(u32x4){PKW(pB1,0),PKW(pB1,2),PKW(pB1,4),PKW(pB1,6)};pw3=(u32x4){PKW(pB1,8),PKW(pB1,10),PKW(pB1,12),PKW(pB1,14)};
    SBAR(); pv(o,vb0+sl_cur,PAF(0),PAF(1),PAF(2),PAF(3)); }
  #undef PKW
  #undef PAF
  #undef VFR
  #undef PIN
  #undef MX3
  #undef GAPA
  #undef GAPB
  #undef EX
  #undef VRD
  #undef KRD
  #undef STEP
  #undef ENDW
  {auto rr=__builtin_amdgcn_permlane32_swap(__float_as_uint(l_reg),__float_as_uint(l_reg),false,false);l_reg=__uint_as_float(rr[0])+__uint_as_float(rr[1]);}
  if(hi==0)wsf[32+r32]=l_reg;asm volatile("s_waitcnt lgkmcnt(0)":::"memory");
  float rli[16];
  #pragma unroll
  for(int r=0;r<16;++r)rli[r]=__builtin_amdgcn_rcpf(wsf[32+crow(r,hi)]);
  bf16*Ow=O+(rowbase+q0+wid*QBLK)*OP+h*D;
  { bf16*stg=(bf16*)(shm+LDS_OST)+wid*2048;
    #pragma unroll
    for(int r=0;r<16;++r){const int orow=crow(r,hi);
      #pragma unroll
      for(int d0=0;d0<2;++d0)stg[orow*64+d0*32+r32]=__float2bfloat16(o[d0][r]*rli[r]);}
    asm volatile("s_waitcnt lgkmcnt(0)":::"memory");
    #pragma unroll
    for(int i=0;i<4;++i){const int row=i*8+(lane>>3),ch=lane&7; const u32x4 v=*(const u32x4*)(stg+row*64+ch*8); ATTN_STORE16(Ow+(long)row*OP+ch*8,v);} }
  asm volatile("s_waitcnt lgkmcnt(0)\n\ts_barrier":::"memory");
  #undef DMA_K
  #undef DMA_V
  #undef CMASK
  #undef START
  #undef RESC
  #undef ROT
}
constexpr int ATTN_LDS_BYTES=LDS_BYTES;
#undef SBAR
#undef WAIT_BAR
}
#define LAS __attribute__((address_space(3)))
#define XB_TMO      128
#define XB_XCNT(j)  (256  + 64 * (j))
#define XB_XSUB(j)  (1280 + 64 * (j))
#define XB_XGEN(j)  (2304 + 64 * (j))
#define XB_TOP      3328
#define XB_TOPGEN   3392
#define XCD_BAR_WORDS 3456
#define XB_SPIN_CAP (1u << 18)

__device__ __forceinline__ unsigned xb_ld(unsigned* p)              { return __hip_atomic_load(p, __ATOMIC_RELAXED, __HIP_MEMORY_SCOPE_AGENT); }
__device__ __forceinline__ unsigned xb_add(unsigned* p, unsigned v) { return __hip_atomic_fetch_add(p, v, __ATOMIC_RELAXED, __HIP_MEMORY_SCOPE_AGENT); }
__device__ __forceinline__ unsigned xb_xcc_id() { return (unsigned)__builtin_amdgcn_s_getreg((3 << 11) | 20) & 0xFu; }
#define XB_SPIN(cond, bar) do { unsigned _sp = 0; while (cond) { __builtin_amdgcn_s_sleep(1); \
    if ((++_sp & 255u) == 0u) { if (xb_ld(&(bar)[XB_TMO])) break; if (_sp > XB_SPIN_CAP) { atomicAdd(&(bar)[XB_TMO], 1u); break; } } } } while (0)

struct XcdBarrier {
    unsigned* bar; unsigned x;
    volatile LAS unsigned* st;
};

__device__ __forceinline__ XcdBarrier xcd_barrier_post(unsigned* bar, volatile LAS unsigned* st, int tid) {
    XcdBarrier b; b.bar = bar; b.x = xb_xcc_id(); b.st = st;
    if (tid == 0) (void)xb_add(&bar[XB_XCNT(b.x)], 1u);
    return b;
}
__device__ __forceinline__ void xcd_barrier_complete(unsigned* bar, unsigned x, unsigned& nloc, unsigned& nx) {
    const unsigned G = gridDim.x * gridDim.y * gridDim.z;
    unsigned sum, cnt, mine, sp = 0u;
    for (;;) {
        sum = 0u; cnt = 0u; mine = 0u;
#pragma unroll
        for (unsigned j = 0; j < 16; ++j) { const unsigned c = xb_ld(&bar[XB_XCNT(j)]); sum += c; cnt += (c > 0u) ? 1u : 0u; mine = (j == x) ? c : mine; }
        if (sum == G) break;
        __builtin_amdgcn_s_sleep(1);
        if ((++sp & 255u) == 0u) { if (xb_ld(&bar[XB_TMO])) break; if (sp > XB_SPIN_CAP) { atomicAdd(&bar[XB_TMO], 1u); break; } }
    }
    nloc = mine > 0u ? mine : 1u; nx = cnt > 0u ? cnt : 1u;
}

__device__ __forceinline__ void xcd_barrier(const XcdBarrier& b, int tid) {
    asm volatile("s_waitcnt vmcnt(0)" ::: "memory");
    __syncthreads();
    if (tid == 0) {
        unsigned* bar = b.bar;
        __builtin_amdgcn_s_waitcnt(0);
        unsigned nloc = b.st[0], nx = b.st[1];
        if (nloc == 0u) { xcd_barrier_complete(bar, b.x, nloc, nx); b.st[0] = nloc; b.st[1] = nx; }
        const unsigned old = xb_add(&bar[XB_XSUB(b.x)], 1u);
        const unsigned gen = old / nloc;
        if (old + 1u == (gen + 1u) * nloc) {
            __builtin_amdgcn_fence(__ATOMIC_RELEASE, "agent");
            asm volatile("s_waitcnt vmcnt(0)" ::: "memory");
            const unsigned og = xb_add(&bar[XB_TOP], 1u);
            const unsigned tg = og / nx;
            if (og + 1u == (tg + 1u) * nx) xb_add(&bar[XB_TOPGEN], 1u);
            else XB_SPIN(xb_ld(&bar[XB_TOPGEN]) == tg, bar);
            __builtin_amdgcn_fence(__ATOMIC_ACQUIRE, "agent");
            xb_add(&bar[XB_XGEN(b.x)], 1u);
            asm volatile("s_waitcnt vmcnt(0)" ::: "memory");
        } else {
            XB_SPIN(xb_ld(&bar[XB_XGEN(b.x)]) == gen, bar);
            __builtin_amdgcn_fence(__ATOMIC_ACQUIRE, "agent");
            asm volatile("s_waitcnt vmcnt(0)" ::: "memory");
        }
    }
    __syncthreads();
}
namespace mk {
typedef unsigned short bf16_t;
typedef float f32x4 __attribute__((ext_vector_type(4)));
typedef float f32x2 __attribute__((ext_vector_type(2)));
typedef unsigned u32x4 __attribute__((ext_vector_type(4)));
typedef unsigned u32x2 __attribute__((ext_vector_type(2)));
constexpr int TA = 16640, TL = 16384, M = 33280, NCH = 130;
constexpr float EPS = 1e-6f;
constexpr float C2 = 0.125f * 1.4426950408889634f;
constexpr size_t MiB = 1u << 20, KiB = 1u << 10;
constexpr size_t WS_WIN = 0, SZ_WIN = (size_t)5376 * 1024 * 2;
constexpr size_t WS_WBRA = 21 * MiB, SZ_WBRA = (size_t)1024 * 512 * 2;
constexpr size_t SZ_WBR3 = (size_t)1024 * 1024 * 2;
constexpr size_t WS_WBRR = 23 * MiB, SZ_WBRR = (size_t)1024 * 256 * 2;
constexpr size_t WS_WBRS = 24 * MiB;
constexpr size_t WS_WOUT = 25 * MiB, SZ_WOUT = (size_t)1024 * 1024 * 2;
constexpr size_t WS_WUP = 29 * MiB, SZ_WUP = (size_t)5632 * 1024 * 2;
constexpr size_t WS_WDN = 51 * MiB, SZ_WDN = (size_t)1024 * 2816 * 2;
constexpr size_t WS_WGLU = 62 * MiB, SZ_WGLU = (size_t)256 * 256 * 2;
constexpr size_t WS_MOD = 62 * MiB + 256 * KiB;
constexpr size_t WS_ROPE = WS_MOD + 160 * KiB;
constexpr size_t WS_LAMB = WS_ROPE + 32 * KiB;
constexpr size_t WS_LAML = WS_LAMB + 32 * KiB;
constexpr size_t WS_BBAR = WS_LAML + 32 * KiB;
constexpr size_t WS_CTL = 63 * MiB, CTL_BYTES = 16 * KiB;
constexpr size_t WS_XC = 64 * MiB;
constexpr size_t WS_H = 66 * MiB;
constexpr size_t WS_YA = WS_H, WS_YR = WS_H + (size_t)M * 512 * 2, WS_YS = WS_YR + (size_t)M * 256 * 2;
constexpr size_t WS_Z = 131 * MiB;
constexpr size_t WS_ZQ = WS_Z, WS_ZKV = WS_ZQ + (size_t)M * 512 * 2, WS_ZH = WS_ZKV + (size_t)M * 256 * 2, WS_ZU = WS_ZH + (size_t)M * 1280 * 2, WS_ZG = WS_ZU + (size_t)M * 256 * 2;
constexpr size_t WS_ZEND = WS_ZG + (size_t)M * 3072 * 2;
constexpr size_t WS_M16 = WS_Z;
constexpr size_t WS_HID = WS_Z;
constexpr size_t WS_PART = WS_Z + 200 * MiB;
constexpr size_t WS_HST = WS_ZEND;
constexpr size_t WS_DJ = WS_HST + (size_t)16 * 130 * 4096 * 4;
constexpr size_t WS_SST = WS_DJ + (size_t)16 * 130 * 64 * 4;
constexpr size_t WS_END = WS_SST + (size_t)64 * 130 * 64 * 8;
static_assert(WS_BBAR + 512 * KiB <= WS_XC && WS_M16 + (size_t)M * 2048 <= WS_ZH + (size_t)M * 512 && WS_HID + (size_t)M * 2816 * 2 <= WS_ZEND && WS_END <= 512 * MiB, "ws map");
constexpr int LDS_BYTES = 8 * 18432 + 1024, LDS_XB = 8 * 18432;

struct Args { const float* in[29]; float* out; unsigned char* ws; int ph_lo, ph_hi; };
typedef const __attribute__((address_space(4))) Args* ArgsP;
__device__ __forceinline__ ArgsP fresh_args() { ArgsP p = (ArgsP)__builtin_amdgcn_kernarg_segment_ptr(); asm volatile("" : "+s"(p)); return p; }

__device__ __forceinline__ float bf2f(unsigned short h) { return __uint_as_float(((unsigned)h) << 16); }
__device__ __forceinline__ unsigned f2bf(float f) { unsigned u = __builtin_bit_cast(unsigned, f); return (u + 0x7fffu + ((u >> 16) & 1u)) >> 16; }

__device__ __forceinline__ unsigned pk2hw(float lo, float hi) { typedef float f2v __attribute__((ext_vector_type(2))); typedef __bf16 b2v __attribute__((ext_vector_type(2))); f2v v = {lo, hi}; return __builtin_bit_cast(unsigned, __builtin_convertvector(v, b2v)); }
__device__ __forceinline__ unsigned pk2(float lo, float hi) { return pk2hw(lo, hi); }
__device__ __forceinline__ float sigm(float x) { return __builtin_amdgcn_rcpf(1.f + __expf(-x)); }
__device__ __forceinline__ float shx(float v, int lane, int m) { return __builtin_bit_cast(float, __builtin_amdgcn_ds_bpermute((lane ^ m) << 2, __builtin_bit_cast(int, v))); }
#define dppf(v, ctrl) __builtin_bit_cast(float, __builtin_amdgcn_update_dpp(0, __builtin_bit_cast(int, (float)(v)), (ctrl), 0xf, 0xf, true))
#define DPP_X1 0xB1
#define DPP_X2 0x4E
#define DPP_HM 0x141
#define DPP_RM 0x140
__device__ __forceinline__ float other32(float v, int hi) { auto rr = __builtin_amdgcn_permlane32_swap(__float_as_uint(v), __float_as_uint(v), false, false); return __uint_as_float(hi ? rr[0] : rr[1]); }
__device__ __forceinline__ float wave_sum(float v, int lane) {
    (void)lane;
    v += dppf(v, DPP_X1); v += dppf(v, DPP_X2); v += dppf(v, DPP_HM); v += dppf(v, DPP_RM);
    const int vi = __builtin_bit_cast(int, v);
    return (__builtin_bit_cast(float, __builtin_amdgcn_readlane(vi, 0)) + __builtin_bit_cast(float, __builtin_amdgcn_readlane(vi, 16)))
         + (__builtin_bit_cast(float, __builtin_amdgcn_readlane(vi, 32)) + __builtin_bit_cast(float, __builtin_amdgcn_readlane(vi, 48)));
}
__device__ __forceinline__ int rowof(int b, int dir, int n) { const int p = dir == 0 ? n : (n < 256 ? 255 - n : 16895 - n); return b * TA + p; }
#define LDS_WAIT() asm volatile("s_waitcnt lgkmcnt(0)" ::: "memory")
#define VM_WAIT() asm volatile("s_waitcnt vmcnt(0)" ::: "memory")

__device__ __forceinline__ void transpose_item(const float* W, int K, int N, bf16_t* WT, int mode, LAS float* scr, int item, int lane, int ldw = 0, int koff = 0) {
    if (ldw == 0) ldw = K;
    const int nblk = N / 32, kb = item / nblk, nb = item % nblk, k0 = 64 * kb, n0 = 32 * nb;
    int r0 = n0;
    if (mode == 1) { r0 = (n0 < 2816) ? (n0 / 128) * 256 + (n0 % 128) : ((n0 - 2816) / 128) * 256 + 128 + ((n0 - 2816) % 128); }
    float wv[32];
#pragma unroll
    for (int i = 0; i < 32; ++i) wv[i] = W[(size_t)(k0 + 2 * i + (lane >> 5)) * N + n0 + (lane & 31)];
#pragma unroll
    for (int i = 0; i < 32; ++i) scr[(2 * i + (lane >> 5)) * 33 + (lane & 31)] = wv[i];
    LDS_WAIT();
    const int c = lane & 7;
#pragma unroll
    for (int j = 0; j < 4; ++j) { const int n = (lane >> 3) + 8 * j; const LAS float* s = scr + (8 * c) * 33 + n;
        u32x4 o; o.x = pk2(s[0 * 33], s[1 * 33]); o.y = pk2(s[2 * 33], s[3 * 33]); o.z = pk2(s[4 * 33], s[5 * 33]); o.w = pk2(s[6 * 33], s[7 * 33]);
        *(u32x4*)(WT + (size_t)(r0 + n) * ldw + koff + k0 + 8 * c) = o; }
    LDS_WAIT();
}

__device__ __forceinline__ void phase_prep(ArgsP A, LAS unsigned char* lds, int tid, int lane, int wave, int G, int bx) {
    unsigned char* ws = A->ws;
    { const int gid = bx * 512 + tid;
      if (gid < 4096) { const int pos = gid >> 4, j = gid & 15; const float inv = powf(10000.f, -(float)(2 * j) / 32.f); const float ang = (float)pos * inv;
          float* rp = (float*)(ws + WS_ROPE); rp[gid * 2] = cosf(ang); rp[gid * 2 + 1] = sinf(ang); }
      else if (gid < 8192) { const int e = gid - 4096;
          const float lre = A->in[13][e], lim = A->in[14][e], dt = expf(A->in[15][e >> 6]);
          const float th = lim * dt, er = expm1f(lre * dt), c = cosf(th), s = sinf(th), sh = sinf(0.5f * th);
          const float m1r = er * c - 2.f * sh * sh, m1i = (er + 1.f) * s;
          float lbr = m1r + 1.f, lbi = m1i;
          const float den = lre * lre + lim * lim, qr = (m1r * lre + m1i * lim) / den, qi = (m1i * lre - m1r * lim) / den;
          float* bb = (float*)(ws + WS_BBAR) + (size_t)e * 32;
          for (int ch = 0; ch < 16; ++ch) { const float br = A->in[16][e * 16 + ch], bi = A->in[17][e * 16 + ch]; bb[2 * ch] = qr * br - qi * bi; bb[2 * ch + 1] = qr * bi + qi * br; }
          float* lb = (float*)(ws + WS_LAMB); lb[2 * e] = lbr; lb[2 * e + 1] = lbi;
          for (int i = 0; i < 7; ++i) { const float r2 = lbr * lbr - lbi * lbi, i2 = 2.f * lbr * lbi; lbr = r2; lbi = i2; }
          float* ll = (float*)(ws + WS_LAML); ll[2 * e] = lbr; ll[2 * e + 1] = lbi; } }
    for (int it = bx; it < 192; it += G) {
        LAS float* cond = (LAS float*)lds;
        for (int i = tid; i < 3072; i += 512) { const int v = i >> 10, k = i & 1023; const float c = v < 2 ? A->in[1][v * 1024 + k] : A->in[3][k]; cond[i] = c / (1.f + expf(-c)); }
        __syncthreads();
        const int l = it / 96, n = (it % 96) * 64 + lane;
        const float* W = A->in[4] + (size_t)l * 1024 * 6144 + n;
        float a0 = 0.f, a1 = 0.f, a2 = 0.f; const int k0 = wave * 128;
        for (int kb = k0; kb < k0 + 128; kb += 32) { float wv[32];
#pragma unroll
            for (int i = 0; i < 32; ++i) wv[i] = W[(size_t)(kb + i) * 6144];
#pragma unroll
            for (int i = 0; i < 32; ++i) { a0 += cond[kb + i] * wv[i]; a1 += cond[1024 + kb + i] * wv[i]; a2 += cond[2048 + kb + i] * wv[i]; } }
        LAS float* red = cond + 3072;
        red[(wave * 3 + 0) * 64 + lane] = a0; red[(wave * 3 + 1) * 64 + lane] = a1; red[(wave * 3 + 2) * 64 + lane] = a2;
        __syncthreads();
        if (wave < 3) { float s = 0.f;
#pragma unroll
            for (int w = 0; w < 8; ++w) s += red[(w * 3 + wave) * 64 + lane];
            s += A->in[5][l * 6144 + n]; ((float*)(ws + WS_MOD))[(l * 3 + wave) * 6144 + n] = s; }
        __syncthreads();
    }
    LAS float* scr = (LAS float*)(lds + wave * 16384);
    const int gw = bx * 8 + wave, NGW = G * 8;
    constexpr int I_IN = 16 * 168, I_BA = 8 * 32, I_BR = 4 * 32, I_OUT = 16 * 32, I_UP = 16 * 176, I_DN = 44 * 32, I_GLU = 4 * 8;
    constexpr int I_L = I_IN + I_BA + 2 * I_BR + I_OUT + I_UP + I_DN + I_GLU;
    for (int it = gw; it < 2 * I_L; it += NGW) {
        const int l = it / I_L; int r = it % I_L;
        if (r < I_IN) { transpose_item(A->in[8] + (size_t)l * 1024 * 5376, 1024, 5376, (bf16_t*)(ws + WS_WIN + l * SZ_WIN), 0, scr, r, lane); continue; } r -= I_IN;
        if (r < I_BA) { transpose_item(A->in[23] + (size_t)l * 512 * 1024, 512, 1024, (bf16_t*)(ws + WS_WBRA + l * SZ_WBR3), 0, scr, r, lane, 1024, 0); continue; } r -= I_BA;
        if (r < I_BR) { transpose_item(A->in[24] + (size_t)l * 256 * 1024, 256, 1024, (bf16_t*)(ws + WS_WBRA + l * SZ_WBR3), 0, scr, r, lane, 1024, 512); continue; } r -= I_BR;
        if (r < I_BR) { transpose_item(A->in[25] + (size_t)l * 256 * 1024, 256, 1024, (bf16_t*)(ws + WS_WBRA + l * SZ_WBR3), 0, scr, r, lane, 1024, 768); continue; } r -= I_BR;
        if (r < I_OUT) { transpose_item(A->in[26] + (size_t)l * 1024 * 1024, 1024, 1024, (bf16_t*)(ws + WS_WOUT + l * SZ_WOUT), 0, scr, r, lane); continue; } r -= I_OUT;
        if (r < I_UP) { transpose_item(A->in[27] + (size_t)l * 1024 * 5632, 1024, 5632, (bf16_t*)(ws + WS_WUP + l * SZ_WUP), 1, scr, r, lane); continue; } r -= I_UP;
        if (r < I_DN) { transpose_item(A->in[28] + (size_t)l * 2816 * 1024, 2816, 1024, (bf16_t*)(ws + WS_WDN + l * SZ_WDN), 0, scr, r, lane); continue; } r -= I_DN;
        transpose_item(A->in[21] + (size_t)l * 256 * 256, 256, 256, (bf16_t*)(ws + WS_WGLU + l * SZ_WGLU), 0, scr, r, lane);
    }
}

__device__ __forceinline__ void phase_norm(ArgsP A, int l, int which, bool from_inputs, int lane, int wave, int G, int bx) {
    unsigned char* ws = A->ws; const int gw = bx * 8 + wave, NGW = G * 8;
    const float* xc = (const float*)(ws + WS_XC);
    const float* gain = A->in[6 + which] + l * 1024;
    for (int r = gw; r < M; r += NGW) {
        const int b = r / TA, p = r - b * TA; const bool ctx = p < 256;
        if (which == 1 && l == 1 && ctx) continue;
        const float* xrow = ctx ? (from_inputs ? A->in[2] : xc) + (size_t)(b * 256 + p) * 1024 : (from_inputs ? A->in[0] : A->out) + ((size_t)b * TL + (p - 256)) * 1024;
        const float* md = (const float*)(ws + WS_MOD) + (l * 3 + (ctx ? 2 : b)) * 6144 + which * 3072;
        f32x4 v[4]; float s = 0.f;
#pragma unroll
        for (int j = 0; j < 4; ++j) v[j] = ((const f32x4*)xrow)[lane + 64 * j];
        if (which == 0 && l == 1 && ctx) {
#pragma unroll
            for (int sl = 0; sl < 3; ++sl) { const f32x4* pr = (const f32x4*)((const float*)(ws + WS_PART) + ((size_t)sl * 512 + (b * 256 + p)) * 1024);
#pragma unroll
                for (int j = 0; j < 4; ++j) v[j] += pr[lane + 64 * j]; } }
#pragma unroll
        for (int j = 0; j < 4; ++j) s += (v[j].x * v[j].x + v[j].y * v[j].y) + (v[j].z * v[j].z + v[j].w * v[j].w);
        const float rstd = __builtin_amdgcn_rsqf(wave_sum(s, lane) * (1.f / 1024.f) + EPS);
        bf16_t* orow = (bf16_t*)(ws + WS_H) + (size_t)r * 1024;
#pragma unroll
        for (int j = 0; j < 4; ++j) { const int c = 4 * (lane + 64 * j);
            const f32x4 g = *(const f32x4*)(gain + c), sh = *(const f32x4*)(md + c), sc = *(const f32x4*)(md + 1024 + c);
            const f32x4 y = (v[j] * rstd) * g * (sc + 1.f) + sh;
            u32x2 o; o.x = pk2(y.x, y.y); o.y = pk2(y.z, y.w); *(u32x2*)(orow + c) = o; }
    }
}

__device__ __forceinline__ float hgrn_lb(ArgsP A, int l, int dir, int h, int lane) {
    if (l == 0) return 0.f;
    const float a0 = A->in[11][(0 * 2 + dir) * 256 + h * 64 + lane], a1 = A->in[11][(1 * 2 + dir) * 256 + h * 64 + lane];
    return 1.f / (1.f + expf(a0 - a1));
}
__device__ __forceinline__ void qk_load(ArgsP A, int r, int lane, unsigned short (&raw)[10]) {
    const bf16_t* zq = (const bf16_t*)(A->ws + WS_ZQ) + (size_t)r * 512; const bf16_t* zk = (const bf16_t*)(A->ws + WS_ZKV) + (size_t)r * 256;
#pragma unroll
    for (int hh = 0; hh < 10; ++hh) raw[hh] = hh < 8 ? zq[hh * 64 + lane] : zk[(hh - 8) * 64 + lane];
}
__device__ __forceinline__ void qk_finish(ArgsP A, int l, int r, int lane, const unsigned short (&raw)[10], float gq, float gk) {
    unsigned char* ws = A->ws;
    const int b = r / TA, p = r - b * TA; const bool lat = p >= 256; const int t = p - 256;
    const int j = lane & 15, pos = (lane < 32) ? (t >> 6) : (t & 63);
    float cs = 1.f, sn = 0.f;
    if (lat) { const f32x2 c2 = ((const f32x2*)(ws + WS_ROPE))[pos * 16 + j]; cs = c2.x; sn = c2.y; }
    bf16_t* zq = (bf16_t*)(ws + WS_ZQ) + (size_t)r * 512; bf16_t* zk = (bf16_t*)(ws + WS_ZKV) + (size_t)r * 256;
#pragma unroll
    for (int hh = 0; hh < 10; ++hh) {
        bf16_t* ptr = hh < 8 ? zq + hh * 64 + lane : zk + (hh - 8) * 64 + lane;
        const float x = bf2f(raw[hh]);
        const float ss = wave_sum(x * x, lane);
        float y = x * __builtin_amdgcn_rsqf(ss * (1.f / 64.f) + EPS) * (hh < 8 ? gq : gk);
        const float pr = shx(y, lane, 16);
        if (lat) y = (lane & 16) ? y * cs + pr * sn : y * cs - pr * sn;
        if (hh < 8) y *= C2;
        *ptr = (bf16_t)f2bf(y);
    }
}
typedef short bf16x8h __attribute__((ext_vector_type(8)));
constexpr int HQS = 72, HTS = 20;
__device__ __forceinline__ bf16x8h frag2(u32x2 lo, u32x2 hi) { u32x4 w; w.x = lo.x; w.y = lo.y; w.z = hi.x; w.w = hi.y; return __builtin_bit_cast(bf16x8h, w); }
template <bool C> __device__ __forceinline__ void hg_load(unsigned short (&rf)[16], unsigned short (&rq)[16], unsigned short (&rv)[16], const bf16_t* Zh, int b, int dir, int h, int n0, int lane) {
    const bf16_t* z0 = Zh + (size_t)rowof(b, dir, n0) * 1280 + h * 64 + lane; const int st = dir == 0 ? 1280 : -1280;
#pragma unroll
    for (int t = 0; t < 16; ++t) { const bf16_t* zr = z0 + t * st;
        rf[t] = zr[256 + dir * 256]; rv[t] = zr[768]; if (C) rq[t] = zr[0]; }
}
template <bool C> __device__ __forceinline__ float hg_stage(const unsigned short (&rf)[16], const unsigned short (&rq)[16], const unsigned short (&rv)[16], LAS bf16_t* L, float lb, int lane) {
    LAS bf16_t* Qt = L; LAS bf16_t* Kh = L + 16 * HQS; LAS bf16_t* KhT = L + 32 * HQS; LAS bf16_t* VT = KhT + 64 * HTS;
    float ec = 1.f; const float omlb = 1.f - lb;
#pragma unroll
    for (int t = 0; t < 16; ++t) {
        const float sg = sigm(bf2f(rf[t])), f = lb + omlb * sg, kin = omlb * (1.f - sg);
        ec *= f;
        const float eic = fminf(__builtin_amdgcn_rcpf(ec), 1.329228e36f);
        float qt = 0.f; if (C) { const float q = bf2f(rq[t]); qt = q * sigm(q) * ec; }
        const unsigned kq = pk2hw(kin * eic, qt);
        const bf16_t kh = (bf16_t)(kq & 0xffffu);
        Kh[t * HQS + lane] = kh; KhT[lane * HTS + t] = kh; VT[lane * HTS + t] = rv[t];
        if (C) Qt[t * HQS + lane] = (bf16_t)(kq >> 16);
    }
    ((LAS float*)(L + 32 * HQS + 128 * HTS))[lane] = ec;
    return ec;
}
__device__ __forceinline__ void hg_state(f32x4 (&S)[4][4], const LAS bf16_t* L, int col, int quad) {
    const LAS bf16_t* KhT = L + 32 * HQS; const LAS bf16_t* VT = KhT + 64 * HTS; const LAS float* Ef = (const LAS float*)(L + 32 * HQS + 128 * HTS);
    const u32x2 z2 = {0u, 0u};
    bf16x8h vf[4];
#pragma unroll
    for (int eb = 0; eb < 4; ++eb) vf[eb] = frag2(*(const LAS u32x2*)(VT + (16 * eb + col) * HTS + 4 * quad), z2);
#pragma unroll
    for (int db = 0; db < 4; ++db) { const bf16x8h ka = frag2(*(const LAS u32x2*)(KhT + (16 * db + col) * HTS + 4 * quad), z2); const f32x4 ef = *(const LAS f32x4*)(Ef + 16 * db + 4 * quad);
#pragma unroll
        for (int eb = 0; eb < 4; ++eb) S[db][eb] = __builtin_amdgcn_mfma_f32_16x16x32_bf16(ka, vf[eb], S[db][eb], 0, 0, 0) * ef; }
}
constexpr int HAS_ = 40;
__device__ __forceinline__ void task_hgrnA(ArgsP A, int l, int task, LAS float* wl, int lane) {
    unsigned char* ws = A->ws;
    const int j = task % NCH, chain = task / NCH, h = chain & 3, dir = (chain >> 2) & 1, b = chain >> 3;
    const float lb = hgrn_lb(A, l, dir, h, lane), omlb = 1.f - lb;
    LAS bf16_t* KtT = (LAS bf16_t*)wl; LAS bf16_t* VT = KtT + 64 * HAS_; LAS float* Ef = (LAS float*)(KtT + 128 * HAS_);
    const bf16_t* Zh = (const bf16_t*)(ws + WS_ZH);
    const int col = lane & 15, quad = lane >> 4;
    f32x4 S[4][4];
#pragma unroll
    for (int db = 0; db < 4; ++db)
#pragma unroll
        for (int eb = 0; eb < 4; ++eb) S[db][eb] = (f32x4){0.f, 0.f, 0.f, 0.f};
    float Dp = 1.f;
    unsigned short rf[32], rv[32];
#define HGA_LOAD(n0_) do { const bf16_t* z0 = Zh + (size_t)rowof(b, dir, (n0_)) * 1280 + h * 64 + lane; const int st = dir == 0 ? 1280 : -1280; \
        _Pragma("unroll") for (int t = 0; t < 32; ++t) { const bf16_t* zr = z0 + t * st; rf[t] = zr[256 + dir * 256]; rv[t] = zr[768]; } } while (0)
    HGA_LOAD(128 * j);
    for (int sb = 0; sb < 4; ++sb) {
        float pr = 1.f;
#pragma unroll
        for (int t = 31; t >= 0; --t) { const float sg = sigm(bf2f(rf[t])), f = lb + omlb * sg, kin = omlb * (1.f - sg);
            KtT[lane * HAS_ + t] = (bf16_t)(pk2hw(kin * pr, 0.f) & 0xffffu); VT[lane * HAS_ + t] = rv[t];
            pr *= f; }
        const float ec = pr; Ef[lane] = ec; Dp *= ec;
        if (sb < 3) HGA_LOAD(128 * j + 32 * (sb + 1));
        LDS_WAIT();
        { bf16x8h vf[4];
#pragma unroll
          for (int eb = 0; eb < 4; ++eb) vf[eb] = *(const LAS bf16x8h*)(VT + (16 * eb + col) * HAS_ + 8 * quad);
#pragma unroll
          for (int db = 0; db < 4; ++db) { const bf16x8h ka = *(const LAS bf16x8h*)(KtT + (16 * db + col) * HAS_ + 8 * quad); const f32x4 ef = *(const LAS f32x4*)(Ef + 16 * db + 4 * quad);
#pragma unroll
              for (int eb = 0; eb < 4; ++eb) S[db][eb] = __builtin_amdgcn_mfma_f32_16x16x32_bf16(ka, vf[eb], S[db][eb] * ef, 0, 0, 0); } }
        LDS_WAIT();
    }
#undef HGA_LOAD
    float* hst = (float*)(ws + WS_HST) + (size_t)(chain * NCH + j) * 4096;
#pragma unroll
    for (int db = 0; db < 4; ++db)
#pragma unroll
        for (int eb = 0; eb < 4; ++eb) { float* p = hst + (16 * db + 4 * quad) * 64 + 16 * eb + col; p[0] = S[db][eb].x; p[64] = S[db][eb].y; p[128] = S[db][eb].z; p[192] = S[db][eb].w; }
    ((float*)(ws + WS_DJ))[(chain * NCH + j) * 64 + lane] = Dp;
}
__device__ __forceinline__ void task_hgrnC(ArgsP A, int l, int task, LAS float* wl, int lane) {
    unsigned char* ws = A->ws;
    const int pb = task % NCH, t2 = task / NCH, h = t2 & 3, b = t2 >> 2;
    if (l == 1 && pb < 2) return;
    LAS bf16_t* L = (LAS bf16_t*)wl; const LAS bf16_t* Qt = L; const LAS bf16_t* Kh = L + 16 * HQS;
    const bf16_t* Zh = (const bf16_t*)(ws + WS_ZH); bf16_t* Yr = (bf16_t*)(ws + WS_H) + 512;
    const int col = lane & 15, quad = lane >> 4;
    float ng[4];
#pragma unroll
    for (int eb = 0; eb < 4; ++eb) ng[eb] = A->in[12][l * 64 + 16 * eb + col];
    for (int dir = 0; dir < 2; ++dir) {
        const int j = dir == 0 ? pb : (pb < 2 ? 1 - pb : 131 - pb), chain = (b * 2 + dir) * 4 + h;
        const float lb = hgrn_lb(A, l, dir, h, lane);
        f32x4 S[4][4];
        { const float* hst = (const float*)(ws + WS_HST) + (size_t)(chain * NCH + j) * 4096;
#pragma unroll
          for (int db = 0; db < 4; ++db)
#pragma unroll
              for (int eb = 0; eb < 4; ++eb) { const float* p = hst + (16 * db + 4 * quad) * 64 + 16 * eb + col; S[db][eb] = (f32x4){p[0], p[64], p[128], p[192]}; } }
        unsigned short rf[16], rq[16], rv[16];
        hg_load<true>(rf, rq, rv, Zh, b, dir, h, 128 * j, lane);
        for (int sb = 0; sb < 8; ++sb) {
            const int n0 = 128 * j + 16 * sb;
            hg_stage<true>(rf, rq, rv, L, lb, lane);
            if (sb < 7) hg_load<true>(rf, rq, rv, Zh, b, dir, h, n0 + 16, lane);
            unsigned short pp[16], pg[16];
            if (dir == 1) {
#pragma unroll
                for (int i = 0; i < 4; ++i) { const size_t row = (size_t)(rowof(b, dir, n0) + (dir == 0 ? 4 * quad + i : -(4 * quad + i)));
#pragma unroll
                    for (int eb = 0; eb < 4; ++eb) { pp[4 * i + eb] = Yr[row * 1024 + h * 64 + 16 * eb + col]; pg[4 * i + eb] = Zh[row * 1280 + 1024 + h * 64 + 16 * eb + col]; } } }
            LDS_WAIT();
            f32x4 pt = {0.f, 0.f, 0.f, 0.f};
#pragma unroll
            for (int kk = 0; kk < 2; ++kk) pt = __builtin_amdgcn_mfma_f32_16x16x32_bf16(*(const LAS bf16x8h*)(Kh + col * HQS + 8 * quad + 32 * kk), *(const LAS bf16x8h*)(Qt + col * HQS + 8 * quad + 32 * kk), pt, 0, 0, 0);
            { const int s0 = 4 * quad; if (s0 + 0 > col) pt.x = 0.f; if (s0 + 1 > col) pt.y = 0.f; if (s0 + 2 > col) pt.z = 0.f; if (s0 + 3 > col) pt.w = 0.f; }
            const u32x2 z2 = {0u, 0u}; u32x2 pw; pw.x = pk2hw(pt.x, pt.y); pw.y = pk2hw(pt.z, pt.w);
            const bf16x8h pf = frag2(pw, z2);
            f32x4 o[4];
            { const LAS bf16_t* VT = L + 32 * HQS + 64 * HTS;
              const bf16x8h qa0 = frag2(*(const LAS u32x2*)(Qt + col * HQS + 4 * quad), *(const LAS u32x2*)(Qt + col * HQS + 16 + 4 * quad));
              const bf16x8h qa1 = frag2(*(const LAS u32x2*)(Qt + col * HQS + 32 + 4 * quad), *(const LAS u32x2*)(Qt + col * HQS + 48 + 4 * quad));
#pragma unroll
              for (int eb = 0; eb < 4; ++eb) {
                  u32x2 a, c; a.x = pk2hw(S[0][eb].x, S[0][eb].y); a.y = pk2hw(S[0][eb].z, S[0][eb].w); c.x = pk2hw(S[1][eb].x, S[1][eb].y); c.y = pk2hw(S[1][eb].z, S[1][eb].w);
                  f32x4 acc = __builtin_amdgcn_mfma_f32_16x16x32_bf16(qa0, frag2(a, c), (f32x4){0.f, 0.f, 0.f, 0.f}, 0, 0, 0);
                  a.x = pk2hw(S[2][eb].x, S[2][eb].y); a.y = pk2hw(S[2][eb].z, S[2][eb].w); c.x = pk2hw(S[3][eb].x, S[3][eb].y); c.y = pk2hw(S[3][eb].z, S[3][eb].w);
                  acc = __builtin_amdgcn_mfma_f32_16x16x32_bf16(qa1, frag2(a, c), acc, 0, 0, 0);
                  o[eb] = __builtin_amdgcn_mfma_f32_16x16x32_bf16(pf, frag2(*(const LAS u32x2*)(VT + (16 * eb + col) * HTS + 4 * quad), z2), acc, 0, 0, 0); } }
            hg_state(S, L, col, quad);
#pragma unroll
            for (int i = 0; i < 4; ++i) { const size_t row = (size_t)(rowof(b, dir, n0) + (dir == 0 ? 4 * quad + i : -(4 * quad + i))); bf16_t* yp = Yr + row * 1024 + h * 64 + col;
                if (dir == 0) {
#pragma unroll
                    for (int eb = 0; eb < 4; eb += 2) { const unsigned w = pk2hw(o[eb][i], o[eb + 1][i]); yp[16 * eb] = (bf16_t)(w & 0xffffu); yp[16 * eb + 16] = (bf16_t)(w >> 16); } }
                else { float tot[4], ss = 0.f;
#pragma unroll
                    for (int eb = 0; eb < 4; ++eb) { tot[eb] = o[eb][i] + bf2f(pp[4 * i + eb]); ss += tot[eb] * tot[eb]; }
                    ss += dppf(ss, DPP_X1); ss += dppf(ss, DPP_X2); ss += dppf(ss, DPP_HM); ss += dppf(ss, DPP_RM);
                    const float rs = __builtin_amdgcn_rsqf(ss * (1.f / 64.f) + EPS);
#pragma unroll
                    for (int eb = 0; eb < 4; eb += 2) { const float g0 = bf2f(pg[4 * i + eb]), g1 = bf2f(pg[4 * i + eb + 1]);
                        const unsigned w = pk2hw(tot[eb] * rs * ng[eb] * (g0 * sigm(g0)), tot[eb + 1] * rs * ng[eb + 1] * (g1 * sigm(g1))); yp[16 * eb] = (bf16_t)(w & 0xffffu); yp[16 * eb + 16] = (bf16_t)(w >> 16); } } }
            LDS_WAIT();
        }
        VM_WAIT();
    }
}
typedef short bf16x8v __attribute__((ext_vector_type(8)));
typedef float f32x16v __attribute__((ext_vector_type(16)));
__device__ __forceinline__ bf16x8v pack8v(const float* f) { u32x4 w; w.x = pk2(f[0], f[1]); w.y = pk2(f[2], f[3]); w.z = pk2(f[4], f[5]); w.w = pk2(f[6], f[7]); return __builtin_bit_cast(bf16x8v, w); }
__device__ __forceinline__ void s5_bfrag(const unsigned char* ws, int ebase, int jj, int hi, bf16x8v (&Bf)[4]) {
#pragma unroll
    for (int ch = 0; ch < 2; ++ch) { const float* bb = (const float*)(ws + WS_BBAR) + (size_t)(ebase + 32 * ch + jj) * 32 + 16 * hi; float re[8], im[8];
#pragma unroll
        for (int q = 0; q < 4; ++q) { const f32x4 v = *(const f32x4*)(bb + 4 * q); re[2 * q] = v.x; im[2 * q] = v.y; re[2 * q + 1] = v.z; im[2 * q + 1] = v.w; }
        Bf[2 * ch] = pack8v(re); Bf[2 * ch + 1] = pack8v(im); }
}
__device__ __forceinline__ void task_s5A(ArgsP A, int l, int task, LAS float* wl, int lane) {
    unsigned char* ws = A->ws;
    const int j = task % NCH, t2 = task / NCH, g = t2 & 15, dir = (t2 >> 4) & 1, b = t2 >> 5;
    const int jj = lane & 31, hi = lane >> 5, ebase = ((l * 2 + dir) * 16 + g) * 64;
    const f32x2 lamA = ((const f32x2*)(ws + WS_LAMB))[ebase + jj], lamB = ((const f32x2*)(ws + WS_LAMB))[ebase + 32 + jj];
    bf16x8v Bf[4]; s5_bfrag(ws, ebase, jj, hi, Bf);
    const bf16_t* Zu = (const bf16_t*)(ws + WS_ZU);
    float xr = 0.f, xi = 0.f;
    const int rb0 = rowof(b, dir, 128 * j), sg_ = dir == 0 ? 1 : -1;
    bf16x8v a1n = *(const bf16x8v*)(Zu + (size_t)(rb0 + sg_ * jj) * 256 + g * 16 + 8 * hi);
    bf16x8v a2n = *(const bf16x8v*)(Zu + (size_t)(rb0 + sg_ * (jj ^ 4)) * 256 + g * 16 + 8 * hi);
    for (int blk = 0; blk < 4; ++blk) {
        const bf16x8v a1 = a1n, a2 = a2n;
        if (blk < 3) { const int o1 = 32 * (blk + 1); a1n = *(const bf16x8v*)(Zu + (size_t)(rb0 + sg_ * (o1 + jj)) * 256 + g * 16 + 8 * hi); a2n = *(const bf16x8v*)(Zu + (size_t)(rb0 + sg_ * (o1 + (jj ^ 4))) * 256 + g * 16 + 8 * hi); }
        const f32x16v z = {0.f, 0.f, 0.f, 0.f, 0.f, 0.f, 0.f, 0.f, 0.f, 0.f, 0.f, 0.f, 0.f, 0.f, 0.f, 0.f};
        const f32x16v c0 = __builtin_amdgcn_mfma_f32_32x32x16_bf16(a1, Bf[0], z, 0, 0, 0), c1 = __builtin_amdgcn_mfma_f32_32x32x16_bf16(a1, Bf[1], z, 0, 0, 0);
        const f32x16v c2 = __builtin_amdgcn_mfma_f32_32x32x16_bf16(a2, Bf[2], z, 0, 0, 0), c3 = __builtin_amdgcn_mfma_f32_32x32x16_bf16(a2, Bf[3], z, 0, 0, 0);
#pragma unroll
        for (int q = 0; q < 8; ++q) { const bool useA = ((q & 1) == hi); const float lr = useA ? lamA.x : lamB.x, li = useA ? lamA.y : lamB.y;
#pragma unroll
            for (int i = 0; i < 4; ++i) { const int r = 4 * (q >> 1) + i; const float bur = useA ? c0[r] : c2[r], bui = useA ? c1[r] : c3[r];
                const float nr = lr * xr - li * xi + bur, ni = lr * xi + li * xr + bui; xr = nr; xi = ni; }
            xr = other32(xr, hi); xi = other32(xi, hi); }
    }
    ((f32x2*)(ws + WS_SST))[((size_t)((b * 2 + dir) * 16 + g) * NCH + j) * 64 + lane] = (f32x2){xr, xi};
}
__device__ __forceinline__ void phase_m1(ArgsP A, int l, LAS unsigned char* lds, int lane, int wave, int G, int bx) {
    LAS float* wl = (LAS float*)(lds + wave * 18432);
    const int gw = bx * 8 + wave, NGW = G * 8;
    constexpr int NH = 16 * NCH, NS = 64 * NCH;
    const bool g256 = (G == 256);
    const int nH = g256 ? (gw < 32 ? 2 : 1) : 0, nS = g256 ? (gw < 32 ? 1 : (gw < 256 ? 5 : 4)) : 0;
    const int nIt = g256 ? nH + nS : (NH + NS - gw + NGW - 1) / NGW;
    for (int ii = 0; ii < nIt; ++ii) { const int i = (wave & 4) ? nIt - 1 - ii : ii; int th = -1, ts = -1;
        if (g256) { if (i < nH) th = gw + 2048 * i; else { const int k = i - nH; ts = gw < 32 ? 8064 + gw : (k < 4 ? (gw - 32) + 2016 * k : 8096 + (gw - 32)); } }
        else { const int t = gw + i * NGW; if (t < NH) th = t; else ts = t - NH; }
        if (th >= 0) task_hgrnA(A, l, th, wl, lane);
        else task_s5A(A, l, ts, wl, lane);
    }
}
__device__ __forceinline__ void phase_m2(ArgsP A, int l, int tid, int G, int bx) {
    unsigned char* ws = A->ws;
    for (int gid = bx * 512 + tid; gid < 65536 + 4096; gid += G * 512) {
        if (gid < 65536) { const int chain = gid >> 12, de = gid & 4095, d = de >> 6;
            float* base = (float*)(ws + WS_HST) + (size_t)chain * NCH * 4096 + de; const float* dj = (const float*)(ws + WS_DJ) + chain * NCH * 64 + d;
            float s = 0.f;
            for (int j0 = 0; j0 < NCH; j0 += 26) { float u[26], dd[26];
#pragma unroll
                for (int i = 0; i < 26; ++i) { u[i] = base[(size_t)(j0 + i) * 4096]; dd[i] = dj[(j0 + i) * 64]; }
#pragma unroll
                for (int i = 0; i < 26; ++i) { base[(size_t)(j0 + i) * 4096] = s; s = dd[i] * s + u[i]; } } }
        else { const int c = gid - 65536, cw = c >> 6, p = c & 63, g = cw & 15, dir = (cw >> 4) & 1;
            const f32x2 lL = ((const f32x2*)(ws + WS_LAML))[((l * 2 + dir) * 16 + g) * 64 + p];
            f32x2* base = (f32x2*)(ws + WS_SST) + (size_t)cw * NCH * 64 + p;
            float er = 0.f, ei = 0.f;
            for (int j0 = 0; j0 < NCH; j0 += 26) { f32x2 u[26];
#pragma unroll
                for (int i = 0; i < 26; ++i) u[i] = base[(j0 + i) * 64];
#pragma unroll
                for (int i = 0; i < 26; ++i) { base[(j0 + i) * 64] = (f32x2){er, ei}; const float nr = lL.x * er - lL.y * ei + u[i].x, ni = lL.x * ei + lL.y * er + u[i].y; er = nr; ei = ni; } } }
    }
}
__device__ __forceinline__ void task_s5C(ArgsP A, int l, int task, LAS float* wl, int lane) {
    unsigned char* ws = A->ws;
    const int pb = task % NCH, t2 = task / NCH, g = t2 & 15, b = t2 >> 4;
    if (l == 1 && pb < 2) return;
    LAS bf16_t* X = (LAS bf16_t*)wl;
    const int jj = lane & 31, hi = lane >> 5;
    const float dsk = A->in[20][l * 256 + g * 16 + (jj & 15)];
    const bf16_t* Zu = (const bf16_t*)(ws + WS_ZU); bf16_t* Ys = (bf16_t*)(ws + WS_H) + 768;
    for (int dir = 0; dir < 2; ++dir) {
        const int j = dir == 0 ? pb : (pb < 2 ? 1 - pb : 131 - pb);
        const int ebase = ((l * 2 + dir) * 16 + g) * 64;
        const f32x2 lamA = ((const f32x2*)(ws + WS_LAMB))[ebase + jj], lamB = ((const f32x2*)(ws + WS_LAMB))[ebase + 32 + jj];
        bf16x8v Bf[4]; s5_bfrag(ws, ebase, jj, hi, Bf);
        bf16x8v Cf[8];
#pragma unroll
        for (int kk = 0; kk < 8; ++kk) { float v[8]; const int p0 = 8 * kk + 4 * hi;
            const size_t co = ((size_t)(((l * 2 + dir) * 16 + g) * 16 + (jj & 15))) * 64 + p0;
            const f32x4 cr = *(const f32x4*)(A->in[18] + co), ci = *(const f32x4*)(A->in[19] + co); const float sgn = (jj < 16) ? 1.f : 0.f;
            v[0] = sgn * cr.x; v[1] = -sgn * ci.x; v[2] = sgn * cr.y; v[3] = -sgn * ci.y; v[4] = sgn * cr.z; v[5] = -sgn * ci.z; v[6] = sgn * cr.w; v[7] = -sgn * ci.w;
            Cf[kk] = pack8v(v); }
        const f32x2 x0 = ((const f32x2*)(ws + WS_SST))[((size_t)((b * 2 + dir) * 16 + g) * NCH + j) * 64 + lane];
        float xr = x0.x, xi = x0.y;
        const int rb0 = rowof(b, dir, 128 * j), sg_ = dir == 0 ? 1 : -1;
        bf16x8v a1n = *(const bf16x8v*)(Zu + (size_t)(rb0 + sg_ * jj) * 256 + g * 16 + 8 * hi);
        bf16x8v a2n = *(const bf16x8v*)(Zu + (size_t)(rb0 + sg_ * (jj ^ 4)) * 256 + g * 16 + 8 * hi);
        for (int blk = 0; blk < 4; ++blk) {
            const int n0 = 128 * j + 32 * blk;
            const bf16x8v a1 = a1n, a2 = a2n;
            if (blk < 3) { const int o1 = 32 * (blk + 1); a1n = *(const bf16x8v*)(Zu + (size_t)(rb0 + sg_ * (o1 + jj)) * 256 + g * 16 + 8 * hi); a2n = *(const bf16x8v*)(Zu + (size_t)(rb0 + sg_ * (o1 + (jj ^ 4))) * 256 + g * 16 + 8 * hi); }
            unsigned short pre[16];
            if (jj < 16) {
#pragma unroll
                for (int r = 0; r < 16; ++r) { const int t = (r & 3) + 8 * (r >> 2) + 4 * hi; const size_t rw = (size_t)(rb0 + sg_ * (32 * blk + t));     pre[r] = dir == 0 ? Zu[rw * 256 + g * 16 + jj] : Ys[rw * 1024 + g * 16 + jj]; } }
            const f32x16v z = {0.f, 0.f, 0.f, 0.f, 0.f, 0.f, 0.f, 0.f, 0.f, 0.f, 0.f, 0.f, 0.f, 0.f, 0.f, 0.f};
            const f32x16v c0 = __builtin_amdgcn_mfma_f32_32x32x16_bf16(a1, Bf[0], z, 0, 0, 0), c1 = __builtin_amdgcn_mfma_f32_32x32x16_bf16(a1, Bf[1], z, 0, 0, 0);
            const f32x16v c2 = __builtin_amdgcn_mfma_f32_32x32x16_bf16(a2, Bf[2], z, 0, 0, 0), c3 = __builtin_amdgcn_mfma_f32_32x32x16_bf16(a2, Bf[3], z, 0, 0, 0);
#pragma unroll
            for (int q = 0; q < 8; ++q) { const bool useA = ((q & 1) == hi); const float lr = useA ? lamA.x : lamB.x, li = useA ? lamA.y : lamB.y; const int pc = useA ? jj : 32 + jj;
#pragma unroll
                for (int i = 0; i < 4; ++i) { const int r = 4 * (q >> 1) + i; const float bur = useA ? c0[r] : c2[r], bui = useA ? c1[r] : c3[r];
                    const float nr = lr * xr - li * xi + bur, ni = lr * xi + li * xr + bui; xr = nr; xi = ni;
                    const int t = 4 * q + i; *(LAS unsigned*)(X + t * 136 + 2 * pc) = pk2hw(xr, xi); }
                xr = other32(xr, hi); xi = other32(xi, hi); }
            LDS_WAIT();
            f32x16v y = z;
#pragma unroll
            for (int kk = 0; kk < 8; ++kk) { const bf16x8v xf = *(const LAS bf16x8v*)(X + jj * 136 + 16 * kk + 8 * hi); y = __builtin_amdgcn_mfma_f32_32x32x16_bf16(xf, Cf[kk], y, 0, 0, 0); }
            if (jj < 16) {
#pragma unroll
                for (int r = 0; r < 16; ++r) { const int t = (r & 3) + 8 * (r >> 2) + 4 * hi; const int row = rb0 + sg_ * (32 * blk + t);
                    bf16_t* yp = Ys + (size_t)row * 1024 + g * 16 + jj;
                    if (dir == 0) *yp = (bf16_t)f2bf(dsk * bf2f(pre[r]) + y[r]);
                    else { const float v = bf2f(pre[r]) + y[r]; const float tt = 1.5957691216f * (v + 0.044715f * v * v * v); *yp = (bf16_t)f2bf(v * __builtin_amdgcn_rcpf(1.f + __expf(-tt))); } } }
            LDS_WAIT();
        }
        VM_WAIT();
    }
}
}

using namespace mk;
#define PHASE_BEGIN { ArgsP A = fresh_args(); if (ph >= A->ph_lo && ph < A->ph_hi) { unsigned char* ws = A->ws; (void)ws; int lane = lane_id_fresh(); int wave = wave0; asm volatile("" : "+s"(wave)); const int tid = wave * 64 + lane; (void)tid; int G = gridDim.x, bx = blockIdx.x; asm volatile("" : "+s"(G), "+s"(bx)); (void)G; (void)bx;
#define PHASE_END   if (ph + 1 < A->ph_hi) xcd_barrier(xbar, wave0 * 64 + lane_id_fresh()); } } ++ph;
template <int l> __device__ __forceinline__ void layer_body(const XcdBarrier& xbar, int& ph, LAS unsigned char* lds, unsigned char* lds_raw, const int wave0) {
        constexpr int lo = (l == 1) ? 1 : 0, nMt = lo ? 128 : 130;
        PHASE_BEGIN phase_norm(A, l, 0, l == 0, lane, wave, G, bx); PHASE_END
        PHASE_BEGIN { pg8::Gemm g{(const bf16_t*)(ws + WS_H), (const bf16_t*)(ws + WS_WIN + l * SZ_WIN), M, 5376, 1024}; pg8::MapOrder S; S.init(130, 5376, G, bx, 0);
            pg8::EpiRoute E{(bf16_t*)(ws + WS_ZQ), (bf16_t*)(ws + WS_ZKV), (bf16_t*)(ws + WS_ZH), (bf16_t*)(ws + WS_ZU), (bf16_t*)(ws + WS_ZG)};
            pg8::gemm_phase<pg8::EpiRoute, pg8::MapOrder, true, true>(lds, g, S, E, wave0); __syncthreads(); } PHASE_END
        PHASE_BEGIN phase_m1(A, l, lds, lane, wave, G, bx); PHASE_END
        PHASE_BEGIN { phase_m2(A, l, tid, G, bx);
            const int nsb = (65536 + 4096 + 511) / 512, fb = (G > nsb + 8) ? nsb : 0, NGW = G * 8, gw = bx * 8 + wave;
            const int R1 = fb > 0 ? M - 7 * NGW : 0;
            const int r0 = (bx - fb) * 8 + wave, rs = (G - fb) * 8;
            const int n1 = (bx >= fb && r0 < R1) ? (R1 - r0 + rs - 1) / rs : 0, n2 = (R1 + gw < M) ? (M - R1 - gw + NGW - 1) / NGW : 0;
            { const float gq = A->in[9][l * 64 + lane], gk = A->in[10][l * 64 + lane];
              unsigned short cur[10], nxt[10];
#define QKROW(i_) ((i_) < n1 ? r0 + (i_) * rs : R1 + gw + ((i_) - n1) * NGW)
              if (n1 + n2 > 0) qk_load(A, QKROW(0), lane, cur);
              for (int i = 0; i < n1 + n2; ++i) { if (i + 1 < n1 + n2) qk_load(A, QKROW(i + 1), lane, nxt); qk_finish(A, l, QKROW(i), lane, cur, gq, gk);
#pragma unroll
                  for (int hh = 0; hh < 10; ++hh) cur[hh] = nxt[hh]; }
#undef QKROW
            } } PHASE_END
        PHASE_BEGIN {
            LAS float* wl = (LAS float*)(lds + wave * 18432);
            const int gw = bx * 8 + wave, NGW = G * 8;
            constexpr int NHC = 8 * NCH, NSC = 32 * NCH;
            (void)gw; (void)NGW;
            { const int th = bx + G * wave; if (th < NHC) task_hgrnC(A, l, th, wl, lane); }
            { int t0 = bx + G * ((wave + 4) & 7), st = 8 * G, n0 = (NSC - t0 + st - 1) / st, tx = -1;
              if (G == 256) { st = 1024;
                  if (wave < 4) { t0 = 0; n0 = 0; if (bx < 16) tx = bx + 1024 * wave; else if (wave == 0 && bx >= 64 && bx < 128) tx = 4096 + bx - 64; }
                  else { t0 = bx + 256 * (wave - 4); n0 = (bx < 16 && wave == 4) ? 0 : 4; } }
              const int nt_ = n0 + (tx >= 0 ? 1 : 0);
              for (int it = 0; it < nt_; ++it) { const int t = it < n0 ? t0 + st * it : tx; task_s5C(A, l, t, wl, lane); } }
            __syncthreads();
            const int NU = (l == 0) ? 1040 : 1024;
            float mfix;
            { float mq = fabsf(A->in[9][l * 64 + lane]), mk_ = fabsf(A->in[10][l * 64 + lane]);
#pragma unroll
              for (int o = 1; o < 64; o <<= 1) { mq = fmaxf(mq, shx(mq, lane, o)); mk_ = fmaxf(mk_, shx(mk_, lane, o)); }
              mfix = 8.f * 1.4426950408889634f * mq * mk_ * 1.02f; }
            for (int u = bx; u < NU; u += G) {
                long rowbase; int q0, NT, h;
                if (u < 1024) { const int qb = u & 63, bh = u >> 6; h = bh & 7; rowbase = (long)(bh >> 3) * TA; q0 = 256 + 256 * qb; NT = 260; }
                else { const int c = u - 1024; h = c & 7; rowbase = (long)(c >> 3) * TA; q0 = 0; NT = 4; }
                attn_body::attn_unit<8, true>(mfix, rowbase, q0, NT, h, h >> 2, (const attn_body::bf16*)(ws + WS_ZQ), (const attn_body::bf16*)(ws + WS_ZKV), (const attn_body::bf16*)(ws + WS_ZKV) + 128, (attn_body::bf16*)(ws + WS_H), (char*)lds_raw, wave0);
            }
            __syncthreads();
        } PHASE_END
        PHASE_BEGIN { pg8::Gemm g{(const bf16_t*)(ws + WS_H) + 768, (const bf16_t*)(ws + WS_WGLU + l * SZ_WGLU), M, 256, 256, 1024}; pg8::MapOrder S; S.init(nMt, 256, G, bx, lo);
            pg8::EpiGlu E{(bf16_t*)(ws + WS_H) + 768, A->in[22] + l * 256, 1024};
            pg8::gemm_phase<pg8::EpiGlu, pg8::MapOrder, true, true>(lds, g, S, E, wave0); __syncthreads(); } PHASE_END
        PHASE_BEGIN { pg8::Gemm g{(const bf16_t*)(ws + WS_H), (const bf16_t*)(ws + WS_WBRA + l * SZ_WBR3), M, 1024, 1024, 0}; pg8::MapOrder S; S.init(nMt, 1024, G, bx, lo);
            pg8::EpiMerge3 E{(bf16_t*)(ws + WS_M16), (const bf16_t*)(ws + WS_ZG)};
            pg8::gemm_phase<pg8::EpiMerge3, pg8::MapOrder, true, true>(lds, g, S, E, wave0); __syncthreads(); } PHASE_END
        PHASE_BEGIN { pg8::Gemm g{(const bf16_t*)(ws + WS_M16), (const bf16_t*)(ws + WS_WOUT + l * SZ_WOUT), M, 1024, 1024}; pg8::MapOrder S; S.init(nMt, 1024, G, bx, lo);
            pg8::EpiResid E{l == 0 ? A->in[0] : A->out, l == 0 ? A->in[2] : (const float*)(ws + WS_XC), A->out, (float*)(ws + WS_XC), (const float*)(ws + WS_MOD) + l * 3 * 6144 + 2 * 1024};
            pg8::gemm_phase<pg8::EpiResid, pg8::MapOrder, true, true>(lds, g, S, E, wave0); __syncthreads(); } PHASE_END
        PHASE_BEGIN phase_norm(A, l, 1, false, lane, wave, G, bx); PHASE_END
        PHASE_BEGIN { pg8::Gemm g{(const bf16_t*)(ws + WS_H), (const bf16_t*)(ws + WS_WUP + l * SZ_WUP), M, 5632, 1024}; pg8::MapOrder S; S.init(nMt, 5632, G, bx, lo);
            pg8::EpiSwiglu E{(bf16_t*)(ws + WS_HID)};
            pg8::gemm_phase<pg8::EpiSwiglu, pg8::MapOrder, true, true>(lds, g, S, E, wave0); __syncthreads(); } PHASE_END
        PHASE_BEGIN { const float* g2 = (const float*)(ws + WS_MOD) + l * 3 * 6144 + 5 * 1024;
            { pg8::Gemm g{(const bf16_t*)(ws + WS_HID), (const bf16_t*)(ws + WS_WDN + l * SZ_WDN), M, 1024, 2816, 0, 0}; pg8::MapOrder S; S.init(128, 1024, G, bx, 1);
              pg8::EpiResid E{A->out, (const float*)(ws + WS_XC), A->out, (float*)(ws + WS_XC), g2};
              pg8::gemm_phase<pg8::EpiResid, pg8::MapOrder, true, true>(lds, g, S, E, wave0); __syncthreads(); }
            if (l == 0) {
                { pg8::Gemm g{(const bf16_t*)(ws + WS_HID), (const bf16_t*)(ws + WS_WDN), M, 1024, 768, 2816, 2816}; pg8::MapOrder S; S.init(2, 1024, G, bx, 2);
                  pg8::EpiResid E{A->out, (const float*)(ws + WS_XC), A->out, (float*)(ws + WS_XC), g2};
                  pg8::gemm_phase<pg8::EpiResid, pg8::MapOrder, true, true>(lds, g, S, E, wave0); __syncthreads(); }
#pragma nounroll
                for (int s = 1; s < 4; ++s) { const int koff = s == 1 ? 768 : s == 2 ? 1536 : 2176, ks = s == 1 ? 768 : 640;
                    pg8::Gemm g{(const bf16_t*)(ws + WS_HID) + koff, (const bf16_t*)(ws + WS_WDN) + koff, M, 1024, ks, 2816, 2816}; pg8::MapOrder S; S.init(2, 1024, G, (bx + G - 8 * s) % G, 2);
                    pg8::EpiPart E{(float*)(ws + WS_PART) + (size_t)(s - 1) * 512 * 1024, g2 + 2 * 6144};
                    pg8::gemm_phase<pg8::EpiPart, pg8::MapOrder, true, true>(lds, g, S, E, wave0); __syncthreads(); } } } PHASE_END
    }

__global__ void __launch_bounds__(512, 2) mk_fwd(mk::Args Aval) {
    using namespace mk;
    extern __shared__ __attribute__((aligned(16))) unsigned char lds_raw[];
    LAS unsigned char* lds = (LAS unsigned char*)lds_raw;
    cooperative_groups::grid_group grid = cooperative_groups::this_grid();
    int ph = 0;
    const int wave0 = __builtin_amdgcn_readfirstlane(threadIdx.x >> 6);
    XcdBarrier xbar;
    { mk::ArgsP A0 = mk::fresh_args(); const int tid0 = threadIdx.x;
      if (tid0 < 8) ((LAS unsigned*)(lds + LDS_XB))[tid0] = 0u;
      __syncthreads();
      xbar = xcd_barrier_post((unsigned*)(A0->ws + WS_CTL), (volatile LAS unsigned*)(lds + LDS_XB), tid0);
      if (A0->ph_lo < 0) grid.sync(); }

    PHASE_BEGIN phase_prep(A, lds, tid, lane, wave, G, bx); PHASE_END

    layer_body<0>(xbar, ph, lds, lds_raw, wave0);
    layer_body<1>(xbar, ph, lds, lds_raw, wave0);
}

#ifndef MK_COOP
#define MK_COOP 1
#endif
extern "C" void kernel_launch(void* const* d_in, const int* in_sizes, int n_in, void* d_out, int out_size, void* d_ws, size_t ws_size, hipStream_t stream) {
    static int grid = 0;
    if (grid == 0) {
        if (n_in != 29 || ws_size < mk::WS_END) { fprintf(stderr, "kernel_launch: bad inputs (n_in %d, ws %zu < %zu)\n", n_in, ws_size, (size_t)mk::WS_END); grid = -1; return; }
        int dev = 0, cus = 0, per_cu = 0;
        hipGetDevice(&dev); hipDeviceGetAttribute(&cus, hipDeviceAttributeMultiprocessorCount, dev);
        hipFuncSetAttribute((const void*)mk_fwd, hipFuncAttributeMaxDynamicSharedMemorySize, mk::LDS_BYTES);
        hipOccupancyMaxActiveBlocksPerMultiprocessor(&per_cu, (const void*)mk_fwd, 512, mk::LDS_BYTES);
        (void)hipGetLastError();
        grid = cus > 0 ? cus : 256;
        fprintf(stderr, "kernel_launch: cus %d per_cu %d grid %d\n", cus, per_cu, grid);
    }
    if (grid < 0) return;
    if (hipMemsetAsync((char*)d_ws + mk::WS_CTL, 0, mk::CTL_BYTES, stream) != hipSuccess) { fprintf(stderr, "memset failed\n"); return; }
    mk::Args a{};
    for (int i = 0; i < 29; ++i) a.in[i] = (const float*)d_in[i];
    a.out = (float*)d_out; a.ws = (unsigned char*)d_ws;
#if MK_COOP
    a.ph_lo = 0; a.ph_hi = 23;
    void* args[] = {&a};
    hipError_t e = hipLaunchCooperativeKernel((const void*)mk_fwd, dim3(grid), dim3(512), args, mk::LDS_BYTES, stream);
    if (e != hipSuccess) fprintf(stderr, "cooperative launch failed: %s\n", hipGetErrorString(e));
#else
    for (int p = 0; p < 23; ++p) { a.ph_lo = p; a.ph_hi = p + 1; hipLaunchKernelGGL(mk_fwd, dim3(grid), dim3(512), mk::LDS_BYTES, stream, a); }
#endif
}
```
